# Optimizing an MI355X kernel written in HIP

```python
import math
import jax, jax.numpy as jnp
from jax import lax
import numpy as np

D_MODEL = 1024
BATCH = 16
SEQ = 2048
DEPTH = 1

MIX_WIDTH = D_MODEL
GDN_HEAD_DIM = 128
GDN_WIDTH = MIX_WIDTH // 2
GDN_HEADS = GDN_WIDTH // GDN_HEAD_DIM
GDN_CONV = 4
GDN_CHUNK = 64
MOBA_HEAD_DIM = 128
MOBA_WIDTH = MIX_WIDTH - GDN_WIDTH
MOBA_HEADS = MOBA_WIDTH // MOBA_HEAD_DIM
MOBA_BLOCK = 256
MOBA_TOPK = 3
MOBA_Q_CHUNK = 16
ROPE_THETA = 500000.0
ROPE_DIMS = MOBA_HEAD_DIM // 4
D_FF = 4 * D_MODEL
PLE_DIM = 256
RMS_EPS = 1e-6
IN_PROJ = 4 * GDN_WIDTH + 2 * GDN_HEADS + 3 * MOBA_WIDTH
IN_SPLITS = (GDN_WIDTH, 2 * GDN_WIDTH, 3 * GDN_WIDTH, 4 * GDN_WIDTH,
             4 * GDN_WIDTH + GDN_HEADS, 4 * GDN_WIDTH + 2 * GDN_HEADS,
             4 * GDN_WIDTH + 2 * GDN_HEADS + MOBA_WIDTH,
             4 * GDN_WIDTH + 2 * GDN_HEADS + 2 * MOBA_WIDTH)

kernel_name = "hybrid_gdn_moba_parallel_block"


def rms_norm(x, w):
    xf = x.astype(jnp.float32)
    y = xf * lax.rsqrt(jnp.mean(xf * xf, axis=-1, keepdims=True) + RMS_EPS)
    return (y * w.astype(jnp.float32)).astype(x.dtype)


def l2_normalize(x):
    xf = x.astype(jnp.float32)
    return xf * lax.rsqrt(jnp.sum(xf * xf, axis=-1, keepdims=True) + RMS_EPS)


def to_heads(t, n_heads):
    b, s, _ = t.shape
    return t.reshape(b, s, n_heads, -1).transpose(0, 2, 1, 3)


def from_heads(t):
    b, h, s, d = t.shape
    return t.transpose(0, 2, 1, 3).reshape(b, s, h * d)


def causal_depthwise_conv(x, w):
    k, c = w.shape
    return lax.conv_general_dilated(
        x, w[:, None, :].astype(x.dtype), window_strides=(1,), padding=[(k - 1, 0)],
        dimension_numbers=('NWC', 'WIO', 'NWC'), feature_group_count=c)


def partial_rotary(x, positions):
    half = ROPE_DIMS // 2
    inv_freq = ROPE_THETA ** (-jnp.arange(half, dtype=jnp.float32) * (2.0 / ROPE_DIMS))
    ang = positions.astype(jnp.float32)[:, None] * inv_freq[None, :]
    cos, sin = jnp.cos(ang), jnp.sin(ang)
    xr = x[..., :ROPE_DIMS].astype(jnp.float32)
    x1, x2 = xr[..., :half], xr[..., half:]
    rot = jnp.concatenate([x1 * cos - x2 * sin, x2 * cos + x1 * sin], axis=-1).astype(x.dtype)
    return jnp.concatenate([rot, x[..., ROPE_DIMS:]], axis=-1)


def chunk_gated_delta_rule(q, k, v, g, beta):
    b, h, t, dk = q.shape
    dv = v.shape[-1]
    c = GDN_CHUNK
    n = t // c
    q = q * (dk ** -0.5)
    q, k, v = (a.reshape(b, h, n, c, a.shape[-1]) for a in (q, k, v))
    g = jnp.cumsum(g.reshape(b, h, n, c), axis=-1)
    beta = beta.reshape(b, h, n, c)[..., None]
    k_beta = k * beta
    causal = jnp.tril(jnp.ones((c, c), dtype=bool))
    strict = jnp.tril(jnp.ones((c, c), dtype=bool), -1)
    decay = jnp.exp(jnp.where(causal, g[..., :, None] - g[..., None, :], -jnp.inf))
    lower = jnp.where(strict, jnp.einsum('bhncd,bhnsd->bhncs', k_beta, k) * decay, 0.0)
    eye = jnp.eye(c, dtype=q.dtype)
    rhs = jnp.concatenate([v * beta, k_beta * jnp.exp(g)[..., None]], axis=-1)
    sol = lax.linalg.triangular_solve(eye + lower, rhs, left_side=True, lower=True)
    u, w = sol[..., :dv], sol[..., dv:]
    intra = jnp.where(causal, jnp.einsum('bhncd,bhnsd->bhncs', q, k) * decay, 0.0)

    def step(state, xs):
        q_i, k_i, u_i, w_i, g_i, a_i = xs
        v_new = u_i - jnp.einsum('bhcd,bhdv->bhcv', w_i, state)
        o_i = (jnp.einsum('bhcd,bhdv->bhcv', q_i * jnp.exp(g_i)[..., None], state)
               + jnp.einsum('bhcs,bhsv->bhcv', a_i, v_new))
        g_last = g_i[..., -1:]
        state = (state * jnp.exp(g_last)[..., None]
                 + jnp.einsum('bhcd,bhcv->bhdv', k_i * jnp.exp(g_last - g_i)[..., None], v_new))
        return state, o_i

    xs = tuple(jnp.moveaxis(a, 2, 0) for a in (q, k, u, w, g, intra))
    s0 = jnp.zeros((b, h, dk, dv), q.dtype)
    _, o = lax.scan(step, s0, xs)
    return jnp.moveaxis(o, 0, 2).reshape(b, h, t, dv)


def gated_deltanet_group(gq, gk, gv, gz, gb, ga, conv_w, a_log, dt_bias, norm_w):
    b, t, _ = gq.shape
    qkv = jax.nn.silu(causal_depthwise_conv(jnp.concatenate([gq, gk, gv], axis=-1), conv_w))
    q, k, v = jnp.split(qkv, 3, axis=-1)
    q = l2_normalize(to_heads(q, GDN_HEADS))
    k = l2_normalize(to_heads(k, GDN_HEADS))
    v = to_heads(v, GDN_HEADS).astype(jnp.float32)
    beta = jax.nn.sigmoid(gb.astype(jnp.float32)).transpose(0, 2, 1)
    g = (-jnp.exp(a_log.astype(jnp.float32))
         * jax.nn.softplus(ga.astype(jnp.float32) + dt_bias.astype(jnp.float32))).transpose(0, 2, 1)
    o = chunk_gated_delta_rule(q, k, v, g, beta).transpose(0, 2, 1, 3)
    z = gz.reshape(b, t, GDN_HEADS, GDN_HEAD_DIM).astype(jnp.float32)
    o = rms_norm(o, norm_w) * jax.nn.silu(z)
    return o.reshape(b, t, GDN_WIDTH).astype(gq.dtype)


def moba_attention(q, k, v):
    b, h, t, d = q.shape
    nb = -(-t // MOBA_BLOCK)
    t_pad = nb * MOBA_BLOCK
    pad = [(0, 0), (0, 0), (0, t_pad - t), (0, 0)]
    kp, vp = jnp.pad(k, pad), jnp.pad(v, pad)
    kb = kp.reshape(b, h, nb, MOBA_BLOCK, d)
    vb = vp.reshape(b, h, nb, MOBA_BLOCK, d)
    k_mean = jnp.mean(kb.astype(jnp.float32), axis=3)
    gate = jnp.einsum('bhtd,bhnd->bhtn', q.astype(jnp.float32), k_mean)
    q_blk = jnp.arange(t) // MOBA_BLOCK
    past = jnp.arange(nb)[None, :] < q_blk[:, None]
    gate = jnp.where(past, gate, -jnp.inf)
    topk = min(MOBA_TOPK, nb)
    _, sel = lax.top_k(gate, topk)
    sel_valid = sel < q_blk[None, None, :, None]
    scale = d ** -0.5
    bi = jnp.arange(b)[:, None, None, None]
    hi = jnp.arange(h)[None, :, None, None]

    def query_chunk(ci):
        t0 = ci * MOBA_Q_CHUNK
        q_c = lax.dynamic_slice_in_dim(q, t0, MOBA_Q_CHUNK, axis=2)
        sel_c = lax.dynamic_slice_in_dim(sel, t0, MOBA_Q_CHUNK, axis=2)
        val_c = lax.dynamic_slice_in_dim(sel_valid, t0, MOBA_Q_CHUNK, axis=2)
        k_sel = kb[bi, hi, sel_c]
        v_sel = vb[bi, hi, sel_c]
        s_sel = jnp.einsum('bhqd,bhqnkd->bhqnk', q_c, k_sel).astype(jnp.float32) * scale
        s_sel = jnp.where(val_c[..., None], s_sel, -jnp.inf).reshape(b, h, MOBA_Q_CHUNK, topk * MOBA_BLOCK)
        blk_start = (t0 // MOBA_BLOCK) * MOBA_BLOCK
        k_own = lax.dynamic_slice_in_dim(kp, blk_start, MOBA_BLOCK, axis=2)
        v_own = lax.dynamic_slice_in_dim(vp, blk_start, MOBA_BLOCK, axis=2)
        s_own = jnp.einsum('bhqd,bhkd->bhqk', q_c, k_own).astype(jnp.float32) * scale
        qpos = t0 + jnp.arange(MOBA_Q_CHUNK)
        kpos = blk_start + jnp.arange(MOBA_BLOCK)
        s_own = jnp.where(kpos[None, :] <= qpos[:, None], s_own, -jnp.inf)
        prob = jax.nn.softmax(jnp.concatenate([s_sel, s_own], axis=-1), axis=-1).astype(v.dtype)
        p_sel = prob[..., :topk * MOBA_BLOCK].reshape(b, h, MOBA_Q_CHUNK, topk, MOBA_BLOCK)
        p_own = prob[..., topk * MOBA_BLOCK:]
        return (jnp.einsum('bhqnk,bhqnkd->bhqd', p_sel, v_sel)
                + jnp.einsum('bhqk,bhkd->bhqd', p_own, v_own))

    out = lax.map(query_chunk, jnp.arange(t // MOBA_Q_CHUNK))
    return jnp.moveaxis(out, 0, 2).reshape(b, h, t, d)


def moba_group(mq, mk, mv, positions):
    q = partial_rotary(to_heads(mq, MOBA_HEADS), positions)
    k = partial_rotary(to_heads(mk, MOBA_HEADS), positions)
    v = to_heads(mv, MOBA_HEADS)
    return from_heads(moba_attention(q, k, v))


def setup_inputs(seed: int = 0) -> dict:
    key = jax.random.key(seed)
    ks = jax.random.split(key, 18)
    f32 = jnp.float32

    def nrm(k, shape, scale):
        return jax.random.normal(k, shape, f32) * scale

    dt = jnp.exp(jax.random.uniform(ks[5], (DEPTH, GDN_HEADS), f32, math.log(1e-3), math.log(1e-1)))
    return {
        "x": nrm(ks[0], (BATCH, SEQ, D_MODEL), 1.0),
        "p": nrm(ks[1], (DEPTH, BATCH, SEQ, PLE_DIM), 1.0),
        "w_in": nrm(ks[2], (DEPTH, D_MODEL, IN_PROJ), D_MODEL ** -0.5),
        "conv_w": nrm(ks[3], (DEPTH, GDN_CONV, 3 * GDN_WIDTH), GDN_CONV ** -0.5),
        "a_log": jnp.log(jax.random.uniform(ks[4], (DEPTH, GDN_HEADS), f32, 1.0, 16.0)),
        "dt_bias": dt + jnp.log(-jnp.expm1(-dt)),
        "gdn_norm_w": 1.0 + nrm(ks[6], (DEPTH, GDN_HEAD_DIM), 0.02),
        "w_out": nrm(ks[7], (DEPTH, MIX_WIDTH, D_MODEL), MIX_WIDTH ** -0.5),
        "attn_pre_norm": 1.0 + nrm(ks[8], (DEPTH, D_MODEL), 0.02),
        "attn_post_norm": 1.0 + nrm(ks[9], (DEPTH, D_MODEL), 0.02),
        "mlp_pre_norm": 1.0 + nrm(ks[10], (DEPTH, D_MODEL), 0.02),
        "mlp_post_norm": 1.0 + nrm(ks[11], (DEPTH, D_MODEL), 0.02),
        "w_up": nrm(ks[12], (DEPTH, D_MODEL, D_FF), D_MODEL ** -0.5),
        "w_down": nrm(ks[13], (DEPTH, D_FF, D_MODEL), D_FF ** -0.5),
        "w_ple": nrm(ks[14], (DEPTH, PLE_DIM, D_MODEL), PLE_DIM ** -0.5),
        "w_ple_gate": nrm(ks[15], (DEPTH, D_MODEL, D_MODEL), D_MODEL ** -0.5),
    }


def reference(x, p, w_in, conv_w, a_log, dt_bias, gdn_norm_w, w_out, attn_pre_norm,
              attn_post_norm, mlp_pre_norm, mlp_post_norm, w_up, w_down, w_ple, w_ple_gate):
    t = x.shape[1]
    positions = jnp.arange(t, dtype=jnp.int32)
    h = x
    for i in range(DEPTH):
        u = rms_norm(h, attn_pre_norm[i])
        proj = u @ w_in[i]
        gq, gk, gv, gz, gb, ga, mq, mk, mv = jnp.split(proj, IN_SPLITS, axis=-1)
        o_gdn = gated_deltanet_group(gq, gk, gv, gz, gb, ga, conv_w[i], a_log[i], dt_bias[i], gdn_norm_w[i])
        o_moba = moba_group(mq, mk, mv, positions)
        mix = jnp.concatenate([o_gdn, o_moba], axis=-1) @ w_out[i]
        h = h + rms_norm(mix, attn_post_norm[i])
        f = jnp.square(jax.nn.relu(rms_norm(h, mlp_pre_norm[i]) @ w_up[i])) @ w_down[i]
        h = h + rms_norm(f, mlp_post_norm[i])
        h = h + jax.nn.sigmoid(h @ w_ple_gate[i]) * (p[i] @ w_ple[i])
    return h
```

```cpp
#include <hip/hip_runtime.h>
#include <hip/hip_cooperative_groups.h>
#include <cstdio>
#include <cstdint>
#include <cmath>
namespace cg = cooperative_groups;
namespace pg8 {
#define PG8_LAS __attribute__((address_space(3)))
typedef unsigned short bf16_t;
typedef short bf16x8 __attribute__((ext_vector_type(8)));
typedef float f32x4 __attribute__((ext_vector_type(4)));
typedef unsigned u32x4 __attribute__((ext_vector_type(4)));
constexpr int BM = 256, BK = 64, HALF = 128, HTB = HALF * BK * 2  , STAGE_BYTES = 8 * HTB, NXCD = 8, WGM = 8;

__host__ __device__ __forceinline__ int lds_byte(int r, int c) { const int st = (r >> 4) * 2 + (c >> 5), rr = r & 15, cc = c & 31, ob = rr * 64 + cc * 2; return st * 1024 + (ob ^ (((ob >> 9) & 1) << 5)); }
__host__ __device__ __forceinline__ void stage_rc(int b, int& R, int& C) { const int st = b / 1024, sb = b % 1024, swz = sb ^ (((sb >> 9) & 1) << 5); R = (st >> 1) * 16 + swz / 64; C = (st & 1) * 32 + (swz % 64) / 2; }
__host__ __device__ __forceinline__ int perm32(int rho) { const int n = rho >> 4, i = rho & 15; return 8 * (i >> 2) + 4 * n + (i & 3); }

struct Unit { int pm, pn; };
struct Gemm { const bf16_t* A; const bf16_t* Bt; int M, N, K; };

struct StaticOrder {
    int nM, nN, nwg, G, c;
    __host__ __device__ void init(int M, int N, int G_, int c_) { nM = M / BM; nN = N / BM; nwg = nM * nN; G = G_; c = c_; }
    __host__ __device__ bool next(int i, Unit& u) const {
        const long L = (long)i * G + c; if (L >= nwg) return false;
        int wgid = (int)L; { const int q = nwg / NXCD, r = nwg % NXCD, xcd = wgid % NXCD, off = wgid / NXCD; wgid = (xcd < r ? xcd * (q + 1) : r * (q + 1) + (xcd - r) * q) + off; }
        const int nig = WGM * nN, gid = wgid / nig, fm = gid * WGM, gsz = (nM - fm) < WGM ? (nM - fm) : WGM;
        u.pm = fm + ((wgid % nig) % gsz); u.pn = (wgid % nig) / gsz; return true;
    }
    __device__ __forceinline__ void a_ready(const Unit&) const {}
    __device__ __forceinline__ void done(const Unit&) const {}
};

__device__ __forceinline__ unsigned cvt_pk_bf16(float lo, float hi) { unsigned r; asm volatile("v_cvt_pk_bf16_f32 %0, %1, %2" : "=v"(r) : "v"(lo), "v"(hi)); return r; }
template <int MODE> struct EpiGen {
    static constexpr bool PERM = true, AFTER_DRAIN = false;
    bf16_t* O; int ldc; float* out; const bf16_t* ple;
    __device__ __forceinline__ void operator()(const f32x4 (&acc)[2][2][4][2], const Unit& u, int wr, int wc, int fr, int fq) const {
        const int row0 = u.pm * BM + wr * 64 + fr; const int col0 = u.pn * BM + wc * 32 + 8 * fq;
#pragma unroll
        for (int ai = 0; ai < 2; ++ai)
#pragma unroll
            for (int m = 0; m < 4; ++m) {
                const size_t row = (size_t)(row0 + ai * HALF + m * 16);
#pragma unroll
                for (int bj = 0; bj < 2; ++bj) {
                    f32x4 v0 = acc[ai][bj][m][0], v1 = acc[ai][bj][m][1];
                    const int col = col0 + bj * HALF;
                    if (MODE == 2) {
                        float* op = out + row * 1024 + col;
                        const f32x4 h0 = *(const f32x4*)op, h1 = *(const f32x4*)(op + 4);
                        const u32x4 pw = *(const u32x4*)(ple + row * 1024 + col);
                        f32x4 p0, p1;
                        p0[0] = __uint_as_float(pw.x << 16); p0[1] = __uint_as_float(pw.x & 0xffff0000u); p0[2] = __uint_as_float(pw.y << 16); p0[3] = __uint_as_float(pw.y & 0xffff0000u);
                        p1[0] = __uint_as_float(pw.z << 16); p1[1] = __uint_as_float(pw.z & 0xffff0000u); p1[2] = __uint_as_float(pw.w << 16); p1[3] = __uint_as_float(pw.w & 0xffff0000u);
                        f32x4 o0, o1;
#pragma unroll
                        for (int e = 0; e < 4; ++e) { o0[e] = h0[e] + p0[e] / (1.f + __expf(-v0[e])); o1[e] = h1[e] + p1[e] / (1.f + __expf(-v1[e])); }
                        *(f32x4*)op = o0; *(f32x4*)(op + 4) = o1;
                    } else {
                        if (MODE == 1) {
#pragma unroll
                            for (int e = 0; e < 4; ++e) { float a = fmaxf(v0[e], 0.f), b = fmaxf(v1[e], 0.f); v0[e] = a * a; v1[e] = b * b; }
                        }
                        u32x4 w; w.x = cvt_pk_bf16(v0[0], v0[1]); w.y = cvt_pk_bf16(v0[2], v0[3]); w.z = cvt_pk_bf16(v1[0], v1[1]); w.w = cvt_pk_bf16(v1[2], v1[3]);
                        *(u32x4*)(O + row * ldc + col) = w;
                    }
                }
            }
    }
};
template <class Epi, class Sched, bool ALIGN_EPI = false, bool SP2 = false>
__device__ __forceinline__ void gemm_phase(PG8_LAS unsigned char* lds, const Gemm g, const Sched& S, const Epi& E) {
    int tid_ = threadIdx.x; asm volatile("" : "+v"(tid_)); const int tid = tid_, wid = __builtin_amdgcn_readfirstlane(tid >> 6), lane = tid & 63, wr = wid >> 2, wc = wid & 3, fr = lane & 15, fq = lane >> 4;
    const int K = g.K, nt = K / BK;
    unsigned voffA[2], voffB[2];
#pragma unroll
    for (int i = 0; i < 2; ++i) { int R, C; stage_rc(tid * 16 + i * 8192, R, C); const int Rb = Epi::PERM ? ((R & ~31) + perm32(R & 31)) : R;
        voffA[i] = (unsigned)(R * K + C) * 2u; voffB[i] = (unsigned)(Rb * K + C) * 2u; }
    const size_t kstep = (size_t)(BK * 2);
    const size_t hstep = (size_t)HALF * K * 2;
    const size_t tstep = 2 * hstep;
    const unsigned ldsw = (unsigned)wid * 1024u;
    const int aoff = lds_byte(wr * 64 + fr, fq * 8), boff = lds_byte(wc * 32 + fr, fq * 8);
#define PG8_SA(b, h) (((b) * 2 + (h)) * HTB)
#define PG8_SB(b, h) ((4 + (b) * 2 + (h)) * HTB)
#define PG8_STAGE(bufoff, gbase, voff) do { _Pragma("unroll") for (int _i = 0; _i < 2; ++_i) \
        __builtin_amdgcn_global_load_lds((const unsigned*)((const char*)(gbase) + (voff)[_i]), (PG8_LAS unsigned*)(lds + (bufoff) + ldsw + _i * 8192), 16, 0, 0); } while (0)
#define PG8_LDA(dst, b, h) do { _Pragma("unroll") for (int m = 0; m < 4; ++m) _Pragma("unroll") for (int k = 0; k < 2; ++k) dst[m][k] = *(const PG8_LAS bf16x8*)(lds + PG8_SA(b, h) + aoff + m * 2048 + k * 1024); } while (0)
#define PG8_LDB(dst, b, h) do { _Pragma("unroll") for (int n = 0; n < 2; ++n) _Pragma("unroll") for (int k = 0; k < 2; ++k) dst[n][k] = *(const PG8_LAS bf16x8*)(lds + PG8_SB(b, h) + boff + n * 2048 + k * 1024); } while (0)
#define PG8_MMA(ai, bj, At, Bt) do { __builtin_amdgcn_s_setprio(1); _Pragma("unroll") for (int m = 0; m < 4; ++m) _Pragma("unroll") for (int n = 0; n < 2; ++n) _Pragma("unroll") for (int k = 0; k < 2; ++k) \
        acc[ai][bj][m][n] = __builtin_amdgcn_mfma_f32_16x16x32_bf16(Bt[n][k], At[m][k], acc[ai][bj][m][n], 0, 0, 0); __builtin_amdgcn_s_setprio(0); } while (0)
#define PG8_WAIT_V(n) asm volatile("s_waitcnt vmcnt(" #n ")" ::: "memory")
#define PG8_WAIT_L(n) asm volatile("s_waitcnt lgkmcnt(" #n ")" ::: "memory")
#define PG8_BAR __builtin_amdgcn_s_barrier()
#define PG8_SCHED __builtin_amdgcn_sched_barrier(0)
    Unit cur, nxt; int ui = 0;
    if (!S.next(0, cur)) return;
    f32x4 acc[2][2][4][2];
#pragma unroll
    for (int a = 0; a < 2; ++a)
#pragma unroll
        for (int b = 0; b < 2; ++b)
#pragma unroll
            for (int m = 0; m < 4; ++m)
#pragma unroll
                for (int n = 0; n < 2; ++n) acc[a][b][m][n] = (f32x4){0.f, 0.f, 0.f, 0.f};
    bf16x8 At[4][2], B0[2][2], B1[2][2];
    const char* cA = (const char*)g.A + (size_t)cur.pm * tstep; const char* cB = (const char*)g.Bt + (size_t)cur.pn * tstep;
    S.a_ready(cur);
    if constexpr (SP2) {
        PG8_STAGE(PG8_SB(0, 0), cB, voffB); PG8_STAGE(PG8_SB(0, 1), cB + hstep, voffB); PG8_STAGE(PG8_SA(0, 0), cA, voffA); PG8_STAGE(PG8_SA(0, 1), cA + hstep, voffA);
        if (wr == 1) PG8_BAR;
        PG8_WAIT_V(2); PG8_BAR;
        PG8_STAGE(PG8_SB(1, 0), cB + kstep, voffB); PG8_STAGE(PG8_SA(1, 0), cA + kstep, voffA); PG8_STAGE(PG8_SB(1, 1), cB + hstep + kstep, voffB);
        PG8_WAIT_V(6); PG8_BAR;
    } else {
        PG8_STAGE(PG8_SB(0, 0), cB, voffB); PG8_STAGE(PG8_SA(0, 0), cA, voffA); PG8_STAGE(PG8_SB(0, 1), cB + hstep, voffB); PG8_STAGE(PG8_SA(0, 1), cA + hstep, voffA);
        if (wr == 1) PG8_BAR;
        PG8_WAIT_V(4); PG8_BAR;
        PG8_STAGE(PG8_SB(1, 0), cB + kstep, voffB); PG8_STAGE(PG8_SA(1, 0), cA + kstep, voffA); PG8_STAGE(PG8_SB(1, 1), cB + hstep + kstep, voffB);
        PG8_WAIT_V(6); PG8_BAR;
    }
    for (;;) {
        const bool has_next = S.next(ui + 1, nxt);
        const char* nA = has_next ? (const char*)g.A + (size_t)nxt.pm * tstep : cA; const char* nB = has_next ? (const char*)g.Bt + (size_t)nxt.pn * tstep : cB;
        for (int t = 0; t < nt; t += 2) {
            const bool last = (t == nt - 2);
            const char* a1 = cA + (size_t)(t + 1) * kstep;
            const char* a2 = last ? nA : cA + (size_t)(t + 2) * kstep; const char* b2 = last ? nB : cB + (size_t)(t + 2) * kstep;
            const char* a3 = a2 + kstep; const char* b3 = b2 + kstep;
            if (last && has_next) S.a_ready(nxt);
            if constexpr (SP2) {
            PG8_LDB(B0, 0, 0); PG8_LDB(B1, 0, 1); PG8_SCHED; PG8_LDA(At, 0, 0); PG8_STAGE(PG8_SA(1, 1), a1 + hstep, voffA);
            PG8_WAIT_V(8); PG8_WAIT_L(0); PG8_BAR; PG8_MMA(0, 0, At, B0); PG8_MMA(0, 1, At, B1); PG8_BAR; PG8_SCHED;
            PG8_LDA(At, 0, 1); PG8_STAGE(PG8_SB(0, 0), b2, voffB); PG8_STAGE(PG8_SB(0, 1), b2 + hstep, voffB); PG8_STAGE(PG8_SA(0, 0), a2, voffA);
            PG8_WAIT_V(8); PG8_WAIT_L(0); PG8_BAR; PG8_MMA(1, 0, At, B0); PG8_MMA(1, 1, At, B1); PG8_BAR; PG8_SCHED;
            PG8_LDB(B0, 1, 0); PG8_LDB(B1, 1, 1); PG8_SCHED; PG8_LDA(At, 1, 0); PG8_STAGE(PG8_SA(0, 1), a2 + hstep, voffA);
            PG8_WAIT_V(8); PG8_WAIT_L(0); PG8_BAR; PG8_MMA(0, 0, At, B0); PG8_MMA(0, 1, At, B1); PG8_BAR; PG8_SCHED;
            PG8_LDA(At, 1, 1); PG8_STAGE(PG8_SB(1, 0), b3, voffB); PG8_STAGE(PG8_SB(1, 1), b3 + hstep, voffB); PG8_STAGE(PG8_SA(1, 0), a3, voffA);
            PG8_WAIT_V(8); PG8_WAIT_L(0); PG8_BAR; PG8_MMA(1, 0, At, B0); PG8_MMA(1, 1, At, B1); PG8_BAR; PG8_SCHED;
            } else {
            PG8_LDB(B0, 0, 0); PG8_SCHED; PG8_LDA(At, 0, 0); PG8_STAGE(PG8_SA(1, 1), a1 + hstep, voffA);
            PG8_WAIT_L(8); PG8_BAR; PG8_WAIT_L(0); PG8_MMA(0, 0, At, B0); PG8_BAR; PG8_SCHED;
            PG8_LDB(B1, 0, 1); PG8_STAGE(PG8_SB(0, 0), b2, voffB);
            PG8_BAR; PG8_WAIT_L(0); PG8_MMA(0, 1, At, B1); PG8_BAR;
            PG8_LDA(At, 0, 1); PG8_STAGE(PG8_SA(0, 0), a2, voffA);
            PG8_BAR; PG8_WAIT_L(0); PG8_MMA(1, 0, At, B0); PG8_BAR; PG8_SCHED;
            PG8_STAGE(PG8_SB(0, 1), b2 + hstep, voffB);
            PG8_WAIT_V(6); PG8_BAR; PG8_MMA(1, 1, At, B1); PG8_BAR;
            PG8_LDB(B0, 1, 0); PG8_SCHED; PG8_LDA(At, 1, 0); PG8_STAGE(PG8_SA(0, 1), a2 + hstep, voffA);
            PG8_WAIT_L(8); PG8_BAR; PG8_WAIT_L(0); PG8_MMA(0, 0, At, B0); PG8_BAR; PG8_SCHED;
            PG8_LDB(B1, 1, 1); PG8_STAGE(PG8_SB(1, 0), b3, voffB);
            PG8_BAR; PG8_WAIT_L(0); PG8_MMA(0, 1, At, B1); PG8_BAR;
            PG8_LDA(At, 1, 1); PG8_STAGE(PG8_SA(1, 0), a3, voffA);
            PG8_BAR; PG8_WAIT_L(0); PG8_MMA(1, 0, At, B0); PG8_BAR; PG8_SCHED;
            PG8_STAGE(PG8_SB(1, 1), b3 + hstep, voffB);
            PG8_WAIT_V(6); PG8_BAR; PG8_MMA(1, 1, At, B1); PG8_BAR;
            }
        }
        if constexpr (ALIGN_EPI) { if (wr == 0) PG8_BAR; }
        if constexpr (!Epi::AFTER_DRAIN) { E(acc, cur, wr, wc, fr, fq); S.done(cur); }
        if (!has_next) break;
#pragma unroll
        for (int a = 0; a < 2; ++a)
#pragma unroll
            for (int b = 0; b < 2; ++b)
#pragma unroll
                for (int m = 0; m < 4; ++m)
#pragma unroll
                    for (int n = 0; n < 2; ++n) acc[a][b][m][n] = (f32x4){0.f, 0.f, 0.f, 0.f};
        cur = nxt; cA = nA; cB = nB; ++ui;
        if constexpr (ALIGN_EPI) { if (wr == 1) PG8_BAR; }
    }
    PG8_WAIT_V(0);
    if constexpr (!ALIGN_EPI) { if (wr == 0) PG8_BAR; }
    PG8_BAR;
    if constexpr (Epi::AFTER_DRAIN) { E.fused(acc, cur, wr, wc, fr, fq, lds, wid, lane); S.done(cur); }
#undef PG8_SA
#undef PG8_SB
#undef PG8_STAGE
#undef PG8_LDA
#undef PG8_LDB
#undef PG8_MMA
#undef PG8_WAIT_V
#undef PG8_WAIT_L
#undef PG8_BAR
#undef PG8_SCHED
}
}
typedef pg8::bf16_t bf16_t;
typedef pg8::bf16x8 bf16x8;
typedef pg8::f32x4 f32x4;
typedef pg8::u32x4 u32x4;
typedef unsigned u32x2 __attribute__((ext_vector_type(2)));
#define LAS __attribute__((address_space(3)))
constexpr int MTOK = 32768, DM = 1024, SEQ = 2048, NPROJ = 3584, DFF = 4096, PLED = 256, LDWIN = 3592;
constexpr int C_GQ = 0, C_GK = 512, C_GV = 1024, C_GZ = 1536, C_MQ = 2048, C_MK = 2560, C_MV = 3072;
constexpr float RMS_EPS = 1e-6f;
constexpr int LDS_BYTES = 143360;
constexpr size_t WS_WIN = 4096, WS_WOUT = WS_WIN + (size_t)NPROJ * DM * 2, WS_WUP = WS_WOUT + (size_t)DM * DM * 2, WS_WDOWN = WS_WUP + (size_t)DFF * DM * 2,
    WS_WGATE = WS_WDOWN + (size_t)DFF * DM * 2, WS_WPLE = WS_WGATE + (size_t)DM * DM * 2, WS_ROPE = WS_WPLE + (size_t)DM * PLED * 2, WS_LG = WS_ROPE + (size_t)SEQ * 32 * 4,
    WS_KMEAN = WS_LG + (size_t)MTOK * 8 * 4, WS_PB = WS_KMEAN + (size_t)64 * 8 * 128 * 4, WS_U = WS_PB + (size_t)MTOK * PLED * 2, WS_VT = WS_U + (size_t)MTOK * DM * 2,
    WS_MIXIN = WS_VT + (size_t)64 * 128 * SEQ * 2, WS_BIG = WS_MIXIN + (size_t)MTOK * DM * 2, WS_END = WS_BIG + (size_t)MTOK * DFF * 2;

struct Params {
    const float *x, *p, *w_in, *conv_w, *a_log, *dt_bias, *gdn_norm_w, *w_out, *n_pre_attn, *n_post_attn, *n_pre_mlp, *n_post_mlp, *w_up, *w_down, *w_ple, *w_gate;
    float* out; unsigned char* ws;
    float inv_freq[16];
};

__device__ __forceinline__ float wave_sum(float v) {
#pragma unroll
    for (int o = 1; o < 64; o <<= 1) v += __shfl_xor(v, o);
    return v;
}
__device__ __forceinline__ float bflo(unsigned w) { return __uint_as_float(w << 16); }
__device__ __forceinline__ float bfhi(unsigned w) { return __uint_as_float(w & 0xffff0000u); }
__device__ __forceinline__ unsigned pk2(float lo, float hi) { return pg8::cvt_pk_bf16(lo, hi); }
__device__ __forceinline__ float silu_f(float v) { return v / (1.f + __expf(-v)); }

__device__ __forceinline__ void transpose_item(const float* W, int ldw, int K, int k0, int srccol0, bf16_t* WT, int n0, float* scr, int lane) {
#pragma unroll 8
    for (int i = 0; i < 32; ++i) { const int kk = 2 * i + (lane >> 5); scr[kk * 33 + (lane & 31)] = W[(size_t)(k0 + kk) * ldw + srccol0 + (lane & 31)]; }
    __builtin_amdgcn_s_waitcnt(0xc07f); asm volatile("s_waitcnt lgkmcnt(0)" ::: "memory");
    const int c = lane & 7;
#pragma unroll
    for (int j = 0; j < 4; ++j) { const int n = (lane >> 3) + 8 * j; const float* s = scr + (8 * c) * 33 + n;
        u32x4 o; o.x = pk2(s[0 * 33], s[1 * 33]); o.y = pk2(s[2 * 33], s[3 * 33]); o.z = pk2(s[4 * 33], s[5 * 33]); o.w = pk2(s[6 * 33], s[7 * 33]);
        *(u32x4*)(WT + (size_t)(n0 + n) * K + k0 + 8 * c) = o; }
    asm volatile("s_waitcnt lgkmcnt(0)" ::: "memory");
}
__device__ __forceinline__ void transpose_matrix(const float* W, int ldw, int K, int N, bool is_win, bf16_t* WT, float* scr, int gw, int NGW, int lane) {
    const int nblk = N / 32, items = (K / 64) * nblk;
    for (int it = gw; it < items; it += NGW) { const int kb = it / nblk, nb = it % nblk; const int n0 = nb * 32; const int src = is_win ? (n0 >= 2048 ? n0 + 8 : n0) : n0;
        transpose_item(W, ldw, K, kb * 64, src, WT, n0, scr, lane); }
}
__device__ __forceinline__ void phase0(const Params& P, unsigned char* smem) {
    const int tid = threadIdx.x, lane = tid & 63, wave = tid >> 6; const int G = gridDim.x; const int gw = blockIdx.x * 8 + wave, NGW = G * 8;
    unsigned char* ws = P.ws;
    float* scr = (float*)(smem + 32768) + wave * (64 * 33);
    float* wl = (float*)smem;
    for (int i = tid; i < 1024 * 8; i += 512) wl[i] = P.w_in[(size_t)(i >> 3) * LDWIN + 2048 + (i & 7)];
    transpose_matrix(P.w_in, LDWIN, DM, NPROJ, true, (bf16_t*)(ws + WS_WIN), scr, gw, NGW, lane);
    transpose_matrix(P.w_out, DM, DM, DM, false, (bf16_t*)(ws + WS_WOUT), scr, gw, NGW, lane);
    transpose_matrix(P.w_up, DFF, DM, DFF, false, (bf16_t*)(ws + WS_WUP), scr, gw, NGW, lane);
    transpose_matrix(P.w_down, DM, DFF, DM, false, (bf16_t*)(ws + WS_WDOWN), scr, gw, NGW, lane);
    transpose_matrix(P.w_gate, DM, DM, DM, false, (bf16_t*)(ws + WS_WGATE), scr, gw, NGW, lane);
    transpose_matrix(P.w_ple, DM, PLED, DM, false, (bf16_t*)(ws + WS_WPLE), scr, gw, NGW, lane);
    { float* rope = (float*)(ws + WS_ROPE);
      for (int i = blockIdx.x * 512 + tid; i < SEQ * 16; i += G * 512) { const int t = i >> 4, d = i & 15; const float ang = (float)t * P.inv_freq[d];
          double rev = (double)ang * 0.15915494309189533577; rev -= __builtin_rint(rev); const float fr = (float)rev;
          rope[t * 32 + d] = __builtin_amdgcn_cosf(fr); rope[t * 32 + 16 + d] = __builtin_amdgcn_sinf(fr); } }
    { bf16_t* pb = (bf16_t*)(ws + WS_PB); const size_t n8 = (size_t)MTOK * PLED / 8;
      for (size_t i = (size_t)blockIdx.x * 512 + tid; i < n8; i += (size_t)G * 512) { const f32x4 a = *(const f32x4*)(P.p + i * 8), b = *(const f32x4*)(P.p + i * 8 + 4);
          u32x4 o; o.x = pk2(a[0], a[1]); o.y = pk2(a[2], a[3]); o.z = pk2(b[0], b[1]); o.w = pk2(b[2], b[3]); *(u32x4*)(pb + i * 8) = o; } }
    __syncthreads();
    { bf16_t* U = (bf16_t*)(ws + WS_U); float* LG = (float*)(ws + WS_LG);
      f32x4 wn[4];
#pragma unroll
      for (int j = 0; j < 4; ++j) wn[j] = *((const f32x4*)P.n_pre_attn + lane + 64 * j);
      for (int m = gw; m < MTOK; m += NGW) {
          const f32x4* xr = (const f32x4*)(P.x + (size_t)m * DM) + lane; f32x4 v[4]; float s = 0.f;
#pragma unroll
          for (int j = 0; j < 4; ++j) { v[j] = xr[64 * j]; s += (v[j][0] * v[j][0] + v[j][1] * v[j][1]) + (v[j][2] * v[j][2] + v[j][3] * v[j][3]); }
          const float rstd = rsqrtf(wave_sum(s) * (1.f / DM) + RMS_EPS);
          float lg[8];
#pragma unroll
          for (int c = 0; c < 8; ++c) lg[c] = 0.f;
#pragma unroll
          for (int j = 0; j < 4; ++j) { v[j] = v[j] * rstd * wn[j];
              u32x2 o; o.x = pk2(v[j][0], v[j][1]); o.y = pk2(v[j][2], v[j][3]); *(u32x2*)(U + (size_t)m * DM + 4 * lane + 256 * j) = o;
#pragma unroll
              for (int e = 0; e < 4; ++e) { const f32x4 w0 = *(const f32x4*)(wl + (4 * lane + 256 * j + e) * 8), w1 = *(const f32x4*)(wl + (4 * lane + 256 * j + e) * 8 + 4);
#pragma unroll
                  for (int c = 0; c < 4; ++c) { lg[c] += v[j][e] * w0[c]; lg[4 + c] += v[j][e] * w1[c]; } } }
#pragma unroll
          for (int c = 0; c < 8; ++c) lg[c] = wave_sum(lg[c]);
          if (lane == 0) { *(f32x4*)(LG + (size_t)m * 8) = (f32x4){lg[0], lg[1], lg[2], lg[3]}; *(f32x4*)(LG + (size_t)m * 8 + 4) = (f32x4){lg[4], lg[5], lg[6], lg[7]}; }
      } }
}

__device__ __forceinline__ void moba_prep(const Params& P, unsigned char* smem) {
    const int tid = threadIdx.x; unsigned char* ws = P.ws;
    bf16_t* PROJ = (bf16_t*)(ws + WS_BIG); const float* rope = (const float*)(ws + WS_ROPE); float* KMEAN = (float*)(ws + WS_KMEAN); bf16_t* VT = (bf16_t*)(ws + WS_VT);
    unsigned char* vt = smem;
    float* red = (float*)(smem + 69632);
    const int p = tid & 15, r = tid >> 4;
    for (int unit = blockIdx.x; unit < 512; unit += gridDim.x) {
        const int bh = unit >> 3, n = unit & 7, b = bh >> 2, h = bh & 3; const int m0 = b * SEQ + n * 256;
        float ksum[8];
#pragma unroll
        for (int e = 0; e < 8; ++e) ksum[e] = 0.f;
        for (int i = 0; i < 8; ++i) { const int row = r + 32 * i, t = n * 256 + row; const size_t m = (size_t)(m0 + row);
#pragma unroll
            for (int ten = 0; ten < 2; ++ten) {
                bf16_t* ptr = PROJ + m * NPROJ + (ten == 0 ? C_MQ : C_MK) + h * 128 + 8 * p;
                const u32x4 w = *(const u32x4*)ptr; u32x4 o; o.x = __shfl_xor(w.x, 2); o.y = __shfl_xor(w.y, 2); o.z = __shfl_xor(w.z, 2); o.w = __shfl_xor(w.w, 2);
                float a[8] = {bflo(w.x), bfhi(w.x), bflo(w.y), bfhi(w.y), bflo(w.z), bfhi(w.z), bflo(w.w), bfhi(w.w)};
                if (p < 4) {
                    const float bb[8] = {bflo(o.x), bfhi(o.x), bflo(o.y), bfhi(o.y), bflo(o.z), bfhi(o.z), bflo(o.w), bfhi(o.w)};
                    const float* cs = rope + t * 32 + 8 * (p & 1);
                    const f32x4 c0 = *(const f32x4*)cs, c1 = *(const f32x4*)(cs + 4), s0 = *(const f32x4*)(cs + 16), s1 = *(const f32x4*)(cs + 20);
                    const float cc[8] = {c0[0], c0[1], c0[2], c0[3], c1[0], c1[1], c1[2], c1[3]}, ss[8] = {s0[0], s0[1], s0[2], s0[3], s1[0], s1[1], s1[2], s1[3]};
#pragma unroll
                    for (int e = 0; e < 8; ++e) a[e] = (p < 2) ? (a[e] * cc[e] - bb[e] * ss[e]) : (a[e] * cc[e] + bb[e] * ss[e]);
                    u32x4 st; st.x = pk2(a[0], a[1]); st.y = pk2(a[2], a[3]); st.z = pk2(a[4], a[5]); st.w = pk2(a[6], a[7]);
                    *(u32x4*)ptr = st;
                }
                if (ten == 1) {
#pragma unroll
                    for (int e = 0; e < 8; ++e) ksum[e] += a[e];
                }
            }
            const u32x4 vv = *(const u32x4*)(PROJ + m * NPROJ + C_MV + h * 128 + 8 * p);
            *(u32x4*)(vt + row * 272 + 16 * p) = vv;
        }
#pragma unroll
        for (int e = 0; e < 8; ++e) red[r * 128 + 8 * p + e] = ksum[e];
        __syncthreads();
        if (tid < 128) { float s = 0.f; for (int q = 0; q < 32; ++q) s += red[q * 128 + tid]; KMEAN[((size_t)bh * 8 + n) * 128 + tid] = s * (1.f / 256.f); }
        { const int d = tid & 127, tg = tid >> 7;
          for (int gi = 0; gi < 8; ++gi) { const int g = tg * 8 + gi, s32 = g >> 2, fq = g & 3; unsigned short e8[8];
#pragma unroll
              for (int j = 0; j < 8; ++j) { const int tok = 32 * s32 + (j < 4 ? 4 * fq + j : 16 + 4 * fq + (j - 4)); e8[j] = *(const unsigned short*)(vt + tok * 272 + 2 * d); }
              u32x4 o; o.x = e8[0] | ((unsigned)e8[1] << 16); o.y = e8[2] | ((unsigned)e8[3] << 16); o.z = e8[4] | ((unsigned)e8[5] << 16); o.w = e8[6] | ((unsigned)e8[7] << 16);
              *(u32x4*)(VT + ((size_t)bh * 128 + d) * SEQ + n * 256 + 8 * g) = o; } }
        __syncthreads();
    }
}

__device__ __forceinline__ void moba_unit(const Params& P, unsigned char* smem, int bh, int qb) {
    int tid_ = threadIdx.x; asm volatile("" : "+v"(tid_)); const int tid = tid_, lane = tid & 63, w = tid >> 6, fr = lane & 15, fq = lane >> 4; const int b = bh >> 2, h = bh & 3;
    unsigned char* ws = P.ws;
    const bf16_t* PROJ = (const bf16_t*)(ws + WS_BIG); const float* KMEAN = (const float*)(ws + WS_KMEAN); const bf16_t* VT = (const bf16_t*)(ws + WS_VT); bf16_t* MIXIN = (bf16_t*)(ws + WS_MIXIN);
    const int qrow0 = qb * 256 + 32 * w;
    bf16x8 qf[2][4];
#pragma unroll
    for (int rt = 0; rt < 2; ++rt)
#pragma unroll
        for (int ks = 0; ks < 4; ++ks) qf[rt][ks] = *(const bf16x8*)(PROJ + (size_t)(b * SEQ + qrow0 + 16 * rt + fr) * NPROJ + C_MQ + h * 128 + 32 * ks + 8 * fq);
    unsigned selmask[2];
    if (qb <= 3) { selmask[0] = selmask[1] = (1u << qb) - 1u; }
    else {
        bf16x8 kmf[4];
#pragma unroll
        for (int ks = 0; ks < 4; ++ks) { const float* src = KMEAN + ((size_t)bh * 8 + (fr & 7)) * 128 + 32 * ks + 8 * fq; const f32x4 a = *(const f32x4*)src, c = *(const f32x4*)(src + 4);
            u32x4 o; o.x = pk2(a[0], a[1]); o.y = pk2(a[2], a[3]); o.z = pk2(c[0], c[1]); o.w = pk2(c[2], c[3]); if (fr >= 8) o = (u32x4){0u, 0u, 0u, 0u};
            kmf[ks] = __builtin_bit_cast(bf16x8, o); }
#pragma unroll
        for (int rt = 0; rt < 2; ++rt) { f32x4 g = {0.f, 0.f, 0.f, 0.f};
#pragma unroll
            for (int ks = 0; ks < 4; ++ks) g = __builtin_amdgcn_mfma_f32_16x16x32_bf16(kmf[ks], qf[rt][ks], g, 0, 0, 0);
            float gv[8];
#pragma unroll
            for (int i = 0; i < 4; ++i) { gv[i] = __shfl(g[i], fr); gv[4 + i] = __shfl(g[i], 16 + fr); }
            unsigned msk = 0u;
#pragma unroll
            for (int rep = 0; rep < 3; ++rep) { float best = -INFINITY; int bi = 0;
#pragma unroll
                for (int n = 0; n < 8; ++n) { const bool ok = (n < qb) && !((msk >> n) & 1u) && (gv[n] > best); best = ok ? gv[n] : best; bi = ok ? n : bi; }
                msk |= 1u << bi; }
            selmask[rt] = msk; }
    }
    f32x4 O[2][8]; float mrun[2], lsum[2];
#pragma unroll
    for (int rt = 0; rt < 2; ++rt) { mrun[rt] = -INFINITY; lsum[rt] = 0.f;
#pragma unroll
        for (int dt = 0; dt < 8; ++dt) O[rt][dt] = (f32x4){0.f, 0.f, 0.f, 0.f}; }
    const int ntiles = (qb + 1) * 4;
    const int krow0 = tid >> 4, kpc = tid & 15;
    const int vrow0 = tid >> 3, vpc = tid & 7;
    const bf16_t* kbase = PROJ + (size_t)(b * SEQ) * NPROJ + C_MK + h * 128 + 8 * kpc;
    const bf16_t* vbase = VT + (size_t)bh * 128 * SEQ + 8 * vpc;
    u32x4 st[4];
#define MOBA_LOAD(key0) do { st[0] = *(const u32x4*)(kbase + (size_t)((key0) + krow0) * NPROJ); st[1] = *(const u32x4*)(kbase + (size_t)((key0) + krow0 + 32) * NPROJ); \
        st[2] = *(const u32x4*)(vbase + (size_t)vrow0 * SEQ + (key0)); st[3] = *(const u32x4*)(vbase + (size_t)(vrow0 + 64) * SEQ + (key0)); } while (0)
#define MOBA_STORE(buf) do { unsigned char* kb_ = smem + (buf) * 35840; unsigned char* vb_ = kb_ + 17408; \
        *(u32x4*)(kb_ + krow0 * 272 + kpc * 16) = st[0]; *(u32x4*)(kb_ + (krow0 + 32) * 272 + kpc * 16) = st[1]; \
        *(u32x4*)(vb_ + vrow0 * 144 + vpc * 16) = st[2]; *(u32x4*)(vb_ + (vrow0 + 64) * 144 + vpc * 16) = st[3]; } while (0)
    MOBA_LOAD(0); MOBA_STORE(0);
    __syncthreads();
    const float SC = 0.08838834764831845f * 1.4426950408889634f;
    for (int tt = 0; tt < ntiles; ++tt) {
        const int n = tt >> 2, key0 = tt * 64; const int buf = tt & 1;
        if (tt + 1 < ntiles) MOBA_LOAD(key0 + 64);
        const unsigned char* kb = smem + buf * 35840; const unsigned char* vb = kb + 17408;
        f32x4 s[2][4];
#pragma unroll
        for (int rt = 0; rt < 2; ++rt)
#pragma unroll
            for (int kt = 0; kt < 4; ++kt) s[rt][kt] = (f32x4){0.f, 0.f, 0.f, 0.f};
#pragma unroll
        for (int kt = 0; kt < 4; ++kt)
#pragma unroll
            for (int ks = 0; ks < 4; ++ks) { const bf16x8 kf = *(const bf16x8*)(kb + (16 * kt + fr) * 272 + (32 * ks + 8 * fq) * 2);
                s[0][kt] = __builtin_amdgcn_mfma_f32_16x16x32_bf16(kf, qf[0][ks], s[0][kt], 0, 0, 0);
                s[1][kt] = __builtin_amdgcn_mfma_f32_16x16x32_bf16(kf, qf[1][ks], s[1][kt], 0, 0, 0);
                if (ks == 3) __builtin_amdgcn_sched_barrier(0); }
        bf16x8 pf[2][2];
#pragma unroll
        for (int rt = 0; rt < 2; ++rt) {
            const int row_t = qrow0 + 16 * rt + fr;
            const bool rowsel = (n < qb) ? (((selmask[rt] >> n) & 1u) != 0u) : true;
            float mx = -INFINITY;
#pragma unroll
            for (int kt = 0; kt < 4; ++kt)
#pragma unroll
                for (int i = 0; i < 4; ++i) { float v = s[rt][kt][i] * SC; const int key = key0 + 16 * kt + 4 * fq + i;
                    if (!rowsel || (n == qb && key > row_t)) v = -INFINITY; s[rt][kt][i] = v; mx = fmaxf(mx, v); }
            mx = fmaxf(mx, __shfl_xor(mx, 16)); mx = fmaxf(mx, __shfl_xor(mx, 32));
            const float mnew = fmaxf(mrun[rt], mx), muse = (mnew == -INFINITY) ? 0.f : mnew;
            const float alpha = exp2f(mrun[rt] - muse); mrun[rt] = mnew;
            float ps = 0.f;
#pragma unroll
            for (int kt = 0; kt < 4; ++kt)
#pragma unroll
                for (int i = 0; i < 4; ++i) { const float pv = exp2f(s[rt][kt][i] - muse); s[rt][kt][i] = pv; ps += pv; }
            lsum[rt] = lsum[rt] * alpha + ps;
#pragma unroll
            for (int sl = 0; sl < 2; ++sl) { u32x4 o; o.x = pk2(s[rt][2 * sl][0], s[rt][2 * sl][1]); o.y = pk2(s[rt][2 * sl][2], s[rt][2 * sl][3]);
                o.z = pk2(s[rt][2 * sl + 1][0], s[rt][2 * sl + 1][1]); o.w = pk2(s[rt][2 * sl + 1][2], s[rt][2 * sl + 1][3]); pf[rt][sl] = __builtin_bit_cast(bf16x8, o); }
#pragma unroll
            for (int dt = 0; dt < 8; ++dt) O[rt][dt] = O[rt][dt] * alpha;
        }
#pragma unroll
        for (int sl = 0; sl < 2; ++sl)
#pragma unroll
            for (int dt = 0; dt < 8; ++dt) { const bf16x8 vf = *(const bf16x8*)(vb + (16 * dt + fr) * 144 + (32 * sl + 8 * fq) * 2);
                O[0][dt] = __builtin_amdgcn_mfma_f32_16x16x32_bf16(vf, pf[0][sl], O[0][dt], 0, 0, 0);
                O[1][dt] = __builtin_amdgcn_mfma_f32_16x16x32_bf16(vf, pf[1][sl], O[1][dt], 0, 0, 0);
                if ((dt & 3) == 3) __builtin_amdgcn_sched_barrier(0); }
        if (tt + 1 < ntiles) MOBA_STORE(buf ^ 1);
        __syncthreads();
    }
#undef MOBA_LOAD
#undef MOBA_STORE
#pragma unroll
    for (int rt = 0; rt < 2; ++rt) { float l = lsum[rt]; l += __shfl_xor(l, 16); l += __shfl_xor(l, 32); const float inv = 1.f / l;
        bf16_t* orow = MIXIN + (size_t)(b * SEQ + qrow0 + 16 * rt + fr) * DM + 512 + h * 128 + 4 * fq;
#pragma unroll
        for (int dt = 0; dt < 8; ++dt) { u32x2 o; o.x = pk2(O[rt][dt][0] * inv, O[rt][dt][1] * inv); o.y = pk2(O[rt][dt][2] * inv, O[rt][dt][3] * inv); *(u32x2*)(orow + 16 * dt) = o; } }
}

__device__ __forceinline__ void gdn_recur(const Params& P, unsigned char* smem, int bh) {
    const int tid = threadIdx.x, lane = tid & 63, wave = tid >> 6; const int b = bh >> 2, h = bh & 3; unsigned char* ws = P.ws;
    const bf16_t* PROJ = (const bf16_t*)(ws + WS_BIG); const float* LG = (const float*)(ws + WS_LG); bf16_t* MIXIN = (bf16_t*)(ws + WS_MIXIN);
    float* Qs = (float*)smem; float* Ks = Qs + 8192; float* Vs = Ks + 8192; float* Os = Vs + 8192; float* red = Os + 8192; float* red2 = red + 512; float* ab = red2 + 512;
    const int j = tid & 127, r = tid >> 7;
    float S[32];
#pragma unroll
    for (int i = 0; i < 32; ++i) S[i] = 0.f;
    const float al = -__expf(P.a_log[h]), dtb = P.dt_bias[h];
    const int p = tid & 15, rr = tid >> 4;
    for (int c = 0; c < 32; ++c) {
        const int t0 = c * 64;
        if (tid < 64) { const size_t m = (size_t)(b * SEQ + t0 + tid); const float gb = LG[m * 8 + h], ga = LG[m * 8 + 4 + h] + dtb;
            const float beta = 1.f / (1.f + __expf(-gb)); const float sp = ga > 20.f ? ga : log1pf(__expf(ga)); ab[2 * tid] = beta; ab[2 * tid + 1] = __expf(al * sp); }
        for (int half = 0; half < 2; ++half) { const int row = rr + 32 * half, t = t0 + row;
#pragma unroll
            for (int ten = 0; ten < 3; ++ten) { const int ch = ten * 512 + h * 128 + 8 * p; float acc[8];
#pragma unroll
                for (int e = 0; e < 8; ++e) acc[e] = 0.f;
#pragma unroll
                for (int tap = 0; tap < 4; ++tap) { const int tt = t - 3 + tap;
                    if (tt >= 0) { const u32x4 w = *(const u32x4*)(PROJ + (size_t)(b * SEQ + tt) * NPROJ + ch);
                        const f32x4 w0 = *(const f32x4*)(P.conv_w + tap * 1536 + ch), w1 = *(const f32x4*)(P.conv_w + tap * 1536 + ch + 4);
                        acc[0] += w0[0] * bflo(w.x); acc[1] += w0[1] * bfhi(w.x); acc[2] += w0[2] * bflo(w.y); acc[3] += w0[3] * bfhi(w.y);
                        acc[4] += w1[0] * bflo(w.z); acc[5] += w1[1] * bfhi(w.z); acc[6] += w1[2] * bflo(w.w); acc[7] += w1[3] * bfhi(w.w); } }
                float ss = 0.f;
#pragma unroll
                for (int e = 0; e < 8; ++e) { acc[e] = silu_f(acc[e]); ss += acc[e] * acc[e]; }
                if (ten < 2) { ss += __shfl_xor(ss, 1); ss += __shfl_xor(ss, 2); ss += __shfl_xor(ss, 4); ss += __shfl_xor(ss, 8);
                    const float sc = rsqrtf(ss + RMS_EPS) * (ten == 0 ? 0.08838834764831845f : 1.f);
#pragma unroll
                    for (int e = 0; e < 8; ++e) acc[e] *= sc; }
                float* dst = (ten == 0 ? Qs : (ten == 1 ? Ks : Vs)) + row * 128 + 8 * p;
                *(f32x4*)dst = (f32x4){acc[0], acc[1], acc[2], acc[3]}; *(f32x4*)(dst + 4) = (f32x4){acc[4], acc[5], acc[6], acc[7]}; } }
        __syncthreads();
        for (int step = 0; step < 64; ++step) {
            const float beta = ab[2 * step], a = ab[2 * step + 1];
            const float* kr = Ks + step * 128 + 32 * r; const float* qr = Qs + step * 128 + 32 * r;
            float kk[32]; float part = 0.f;
#pragma unroll
            for (int i = 0; i < 8; ++i) { const f32x4 k4 = *(const f32x4*)(kr + 4 * i); kk[4 * i] = k4[0]; kk[4 * i + 1] = k4[1]; kk[4 * i + 2] = k4[2]; kk[4 * i + 3] = k4[3]; }
#pragma unroll
            for (int i = 0; i < 32; ++i) part += kk[i] * S[i];
            red[r * 128 + j] = part;
            __syncthreads();
            const float kS = (red[j] + red[128 + j]) + (red[256 + j] + red[384 + j]);
            const float cj = beta * (Vs[step * 128 + j] - a * kS);
            float op = 0.f;
#pragma unroll
            for (int i = 0; i < 8; ++i) { const f32x4 q4 = *(const f32x4*)(qr + 4 * i);
#pragma unroll
                for (int e = 0; e < 4; ++e) { S[4 * i + e] = a * S[4 * i + e] + kk[4 * i + e] * cj; op += q4[e] * S[4 * i + e]; } }
            red2[r * 128 + j] = op;
            __syncthreads();
            if (r == 0) Os[step * 128 + j] = (red2[j] + red2[128 + j]) + (red2[256 + j] + red2[384 + j]);
        }
        __syncthreads();
        { const float nw0 = P.gdn_norm_w[2 * lane], nw1 = P.gdn_norm_w[2 * lane + 1];
          for (int q = 0; q < 8; ++q) { const int row = wave * 8 + q; const size_t m = (size_t)(b * SEQ + t0 + row);
              const float o0 = Os[row * 128 + 2 * lane], o1 = Os[row * 128 + 2 * lane + 1];
              const float rstd = rsqrtf(wave_sum(o0 * o0 + o1 * o1) * (1.f / 128.f) + RMS_EPS);
              const unsigned zw = *(const unsigned*)(PROJ + m * NPROJ + C_GZ + h * 128 + 2 * lane);
              *(unsigned*)(MIXIN + m * DM + h * 128 + 2 * lane) = pk2(o0 * rstd * nw0 * silu_f(bflo(zw)), o1 * rstd * nw1 * silu_f(bfhi(zw))); } }
        __syncthreads();
    }
}

__device__ __forceinline__ void rowpass1(const Params& P) {
    const int tid = threadIdx.x, lane = tid & 63, wave = tid >> 6; const int gw = blockIdx.x * 8 + wave, NGW = gridDim.x * 8; unsigned char* ws = P.ws;
    const bf16_t* MIX = (const bf16_t*)(ws + WS_BIG); bf16_t* U = (bf16_t*)(ws + WS_U);
    f32x4 w1[4], w2[4];
#pragma unroll
    for (int jj = 0; jj < 4; ++jj) { w1[jj] = *((const f32x4*)P.n_post_attn + lane + 64 * jj); w2[jj] = *((const f32x4*)P.n_pre_mlp + lane + 64 * jj); }
    for (int m = gw; m < MTOK; m += NGW) {
        f32x4 mv[4], xv[4]; float s = 0.f;
#pragma unroll
        for (int jj = 0; jj < 4; ++jj) { const u32x2 w = *(const u32x2*)(MIX + (size_t)m * DM + 4 * lane + 256 * jj); mv[jj] = (f32x4){bflo(w.x), bfhi(w.x), bflo(w.y), bfhi(w.y)};
            xv[jj] = *((const f32x4*)(P.x + (size_t)m * DM) + lane + 64 * jj); s += (mv[jj][0] * mv[jj][0] + mv[jj][1] * mv[jj][1]) + (mv[jj][2] * mv[jj][2] + mv[jj][3] * mv[jj][3]); }
        const float r1 = rsqrtf(wave_sum(s) * (1.f / DM) + RMS_EPS); float s2 = 0.f;
#pragma unroll
        for (int jj = 0; jj < 4; ++jj) { xv[jj] = xv[jj] + mv[jj] * r1 * w1[jj]; *((f32x4*)(P.out + (size_t)m * DM) + lane + 64 * jj) = xv[jj];
            s2 += (xv[jj][0] * xv[jj][0] + xv[jj][1] * xv[jj][1]) + (xv[jj][2] * xv[jj][2] + xv[jj][3] * xv[jj][3]); }
        const float r2 = rsqrtf(wave_sum(s2) * (1.f / DM) + RMS_EPS);
#pragma unroll
        for (int jj = 0; jj < 4; ++jj) { const f32x4 a = xv[jj] * r2 * w2[jj]; u32x2 o; o.x = pk2(a[0], a[1]); o.y = pk2(a[2], a[3]); *(u32x2*)(U + (size_t)m * DM + 4 * lane + 256 * jj) = o; }
    }
}
__device__ __forceinline__ void rowpass2(const Params& P) {
    const int tid = threadIdx.x, lane = tid & 63, wave = tid >> 6; const int gw = blockIdx.x * 8 + wave, NGW = gridDim.x * 8; unsigned char* ws = P.ws;
    const bf16_t* F = (const bf16_t*)(ws + WS_U); bf16_t* H2B = (bf16_t*)(ws + WS_MIXIN);
    f32x4 w1[4];
#pragma unroll
    for (int jj = 0; jj < 4; ++jj) w1[jj] = *((const f32x4*)P.n_post_mlp + lane + 64 * jj);
    for (int m = gw; m < MTOK; m += NGW) {
        f32x4 fv[4], hv[4]; float s = 0.f;
#pragma unroll
        for (int jj = 0; jj < 4; ++jj) { const u32x2 w = *(const u32x2*)(F + (size_t)m * DM + 4 * lane + 256 * jj); fv[jj] = (f32x4){bflo(w.x), bfhi(w.x), bflo(w.y), bfhi(w.y)};
            hv[jj] = *((const f32x4*)(P.out + (size_t)m * DM) + lane + 64 * jj); s += (fv[jj][0] * fv[jj][0] + fv[jj][1] * fv[jj][1]) + (fv[jj][2] * fv[jj][2] + fv[jj][3] * fv[jj][3]); }
        const float r1 = rsqrtf(wave_sum(s) * (1.f / DM) + RMS_EPS);
#pragma unroll
        for (int jj = 0; jj < 4; ++jj) { hv[jj] = hv[jj] + fv[jj] * r1 * w1[jj]; *((f32x4*)(P.out + (size_t)m * DM) + lane + 64 * jj) = hv[jj];
            u32x2 o; o.x = pk2(hv[jj][0], hv[jj][1]); o.y = pk2(hv[jj][2], hv[jj][3]); *(u32x2*)(H2B + (size_t)m * DM + 4 * lane + 256 * jj) = o; }
    }
}

template <int MODE> __device__ __forceinline__ void run_gemm(unsigned char* smem, const bf16_t* A, const bf16_t* Bt, int N, int K, bf16_t* O, int ldc, float* out, const bf16_t* ple) {
    pg8::Gemm g{A, Bt, MTOK, N, K}; pg8::StaticOrder S; S.init(MTOK, N, (int)gridDim.x, (int)blockIdx.x);
    pg8::EpiGen<MODE> E{O, ldc, out, ple};
#ifndef NO_GEMM
    pg8::gemm_phase<pg8::EpiGen<MODE>, pg8::StaticOrder, true, true>((PG8_LAS unsigned char*)smem, g, S, E);
#endif
    __syncthreads();
}

__global__ void __launch_bounds__(512) fwd_megakernel(Params P) {
    extern __shared__ __attribute__((aligned(16))) unsigned char smem[];
    cg::grid_group grid = cg::this_grid();
    unsigned char* ws = P.ws;
    phase0(P, smem);
    grid.sync();
    run_gemm<0>(smem, (const bf16_t*)(ws + WS_U), (const bf16_t*)(ws + WS_WIN), NPROJ, DM, (bf16_t*)(ws + WS_BIG), NPROJ, nullptr, nullptr);
    grid.sync();
    moba_prep(P, smem);
    grid.sync();
    { const int G = gridDim.x; const int ngdn = 64;
      if ((int)blockIdx.x < ngdn) {
#ifndef NO_GDN
 for (int bh = blockIdx.x; bh < 64; bh += ngdn) gdn_recur(P, smem, bh);
#endif
 }
      else { for (int u = blockIdx.x - ngdn; u < 256; u += G - ngdn) { const int bh = u >> 2, pr = u & 3;
#ifndef NO_MOBA
 for (int rep = 0; rep < 2; ++rep) moba_unit(P, smem, bh, rep == 0 ? 7 - pr : pr);
#endif
 } } }
    grid.sync();
    run_gemm<0>(smem, (const bf16_t*)(ws + WS_MIXIN), (const bf16_t*)(ws + WS_WOUT), DM, DM, (bf16_t*)(ws + WS_BIG), DM, nullptr, nullptr);
    grid.sync();
    rowpass1(P);
    grid.sync();
    run_gemm<1>(smem, (const bf16_t*)(ws + WS_U), (const bf16_t*)(ws + WS_WUP), DFF, DM, (bf16_t*)(ws + WS_BIG), DFF, nullptr, nullptr);
    grid.sync();
    run_gemm<0>(smem, (const bf16_t*)(ws + WS_BIG), (const bf16_t*)(ws + WS_WDOWN), DM, DFF, (bf16_t*)(ws + WS_U), DM, nullptr, nullptr);
    grid.sync();
    rowpass2(P);
    run_gemm<0>(smem, (const bf16_t*)(ws + WS_PB), (const bf16_t*)(ws + WS_WPLE), DM, PLED, (bf16_t*)(ws + WS_BIG), DM, nullptr, nullptr);
    grid.sync();
    run_gemm<2>(smem, (const bf16_t*)(ws + WS_MIXIN), (const bf16_t*)(ws + WS_WGATE), DM, DM, nullptr, DM, P.out, (const bf16_t*)(ws + WS_BIG));
}

extern "C" void kernel_launch(void* const* d_in, const int* in_sizes, int n_in, void* d_out, int out_size, void* d_ws, size_t ws_size, hipStream_t stream) {
    static int grid_blocks = 0;
    if (grid_blocks == 0) {
        if (ws_size < WS_END) { fprintf(stderr, "kernel_launch: workspace too small: %zu < %zu\n", ws_size, (size_t)WS_END); grid_blocks = -1; return; }
        int dev = 0, cus = 0, per_cu = 0;
        hipGetDevice(&dev); hipDeviceGetAttribute(&cus, hipDeviceAttributeMultiprocessorCount, dev);
        hipFuncSetAttribute((const void*)fwd_megakernel, hipFuncAttributeMaxDynamicSharedMemorySize, LDS_BYTES);
        hipOccupancyMaxActiveBlocksPerMultiprocessor(&per_cu, (const void*)fwd_megakernel, 512, LDS_BYTES);
        if (per_cu < 1) { fprintf(stderr, "kernel_launch: occupancy query says %d blocks per CU\n", per_cu); per_cu = 1; }
        grid_blocks = cus;
        if (grid_blocks > 256) grid_blocks = 256;
    }
    if (grid_blocks < 0) return;
    Params P{};
    P.x = (const float*)d_in[0]; P.p = (const float*)d_in[1]; P.w_in = (const float*)d_in[2]; P.conv_w = (const float*)d_in[3]; P.a_log = (const float*)d_in[4]; P.dt_bias = (const float*)d_in[5];
    P.gdn_norm_w = (const float*)d_in[6]; P.w_out = (const float*)d_in[7]; P.n_pre_attn = (const float*)d_in[8]; P.n_post_attn = (const float*)d_in[9]; P.n_pre_mlp = (const float*)d_in[10];
    P.n_post_mlp = (const float*)d_in[11]; P.w_up = (const float*)d_in[12]; P.w_down = (const float*)d_in[13]; P.w_ple = (const float*)d_in[14]; P.w_gate = (const float*)d_in[15];
    P.out = (float*)d_out; P.ws = (unsigned char*)d_ws;
    for (int d = 0; d < 16; ++d) P.inv_freq[d] = (float)std::pow(500000.0, -(double)d / 16.0);
    void* args[] = {&P};
    hipError_t e = hipLaunchCooperativeKernel((const void*)fwd_megakernel, dim3(grid_blocks), dim3(512), args, LDS_BYTES, stream);
    if (e != hipSuccess) fprintf(stderr, "cooperative launch failed: %s (grid %d)\n", hipGetErrorString(e), grid_blocks);
}
```

```cpp
#include <hip/hip_runtime.h>
#include <hip/hip_cooperative_groups.h>
#include <cstdio>
#include <cstdint>
#include <cmath>
namespace cg = cooperative_groups;
namespace pg8 {
#define PG8_LAS __attribute__((address_space(3)))
typedef unsigned short bf16_t;
typedef short bf16x8 __attribute__((ext_vector_type(8)));
typedef float f32x4 __attribute__((ext_vector_type(4)));
typedef unsigned u32x4 __attribute__((ext_vector_type(4)));
constexpr int BM = 256, BK = 64, HALF = 128, HTB = HALF * BK * 2  , STAGE_BYTES = 8 * HTB, NXCD = 8, WGM = 8;

__host__ __device__ __forceinline__ int lds_byte(int r, int c) { const int st = (r >> 4) * 2 + (c >> 5), rr = r & 15, cc = c & 31, ob = rr * 64 + cc * 2; return st * 1024 + (ob ^ (((ob >> 9) & 1) << 5)); }
__host__ __device__ __forceinline__ void stage_rc(int b, int& R, int& C) { const int st = b / 1024, sb = b % 1024, swz = sb ^ (((sb >> 9) & 1) << 5); R = (st >> 1) * 16 + swz / 64; C = (st & 1) * 32 + (swz % 64) / 2; }
__host__ __device__ __forceinline__ int perm32(int rho) { const int n = rho >> 4, i = rho & 15; return 8 * (i >> 2) + 4 * n + (i & 3); }

struct Unit { int pm, pn; };
struct Gemm { const bf16_t* A; const bf16_t* Bt; int M, N, K; };

struct StaticOrder {
    int nM, nN, nwg, G, c;
    __host__ __device__ void init(int M, int N, int G_, int c_) { nM = M / BM; nN = N / BM; nwg = nM * nN; G = G_; c = c_; }
    __host__ __device__ bool next(int i, Unit& u) const {
        const long L = (long)i * G + c; if (L >= nwg) return false;
        int wgid = (int)L; { const int q = nwg / NXCD, r = nwg % NXCD, xcd = wgid % NXCD, off = wgid / NXCD; wgid = (xcd < r ? xcd * (q + 1) : r * (q + 1) + (xcd - r) * q) + off; }
        const int nig = WGM * nN, gid = wgid / nig, fm = gid * WGM, gsz = (nM - fm) < WGM ? (nM - fm) : WGM;
        u.pm = fm + ((wgid % nig) % gsz); u.pn = (wgid % nig) / gsz; return true;
    }
    __device__ __forceinline__ void a_ready(const Unit&) const {}
    __device__ __forceinline__ void done(const Unit&) const {}
};

typedef __bf16 bf16x2_cv __attribute__((ext_vector_type(2)));
typedef float f32x2_cv __attribute__((ext_vector_type(2)));
__device__ __forceinline__ unsigned cvt_pk_bf16(float lo, float hi) { f32x2_cv v = {lo, hi}; bf16x2_cv b = __builtin_convertvector(v, bf16x2_cv); return __builtin_bit_cast(unsigned, b); }
template <int MODE> struct EpiGen {
    static constexpr bool PERM = true, AFTER_DRAIN = false;
    bf16_t* O; int ldc; float* out; const bf16_t* ple;
    __device__ __forceinline__ void operator()(const f32x4 (&acc)[2][2][4][2], const Unit& u, int wr, int wc, int fr, int fq) const {
        const int row0 = u.pm * BM + wr * 64 + fr; const int col0 = u.pn * BM + wc * 32 + 8 * fq;
#pragma unroll
        for (int ai = 0; ai < 2; ++ai)
#pragma unroll
            for (int m = 0; m < 4; ++m) {
                const size_t row = (size_t)(row0 + ai * HALF + m * 16);
#pragma unroll
                for (int bj = 0; bj < 2; ++bj) {
                    f32x4 v0 = acc[ai][bj][m][0], v1 = acc[ai][bj][m][1];
                    const int col = col0 + bj * HALF;
                    if (MODE == 2) {
                        float* op = out + row * 1024 + col;
                        const f32x4 h0 = *(const f32x4*)op, h1 = *(const f32x4*)(op + 4);
                        const u32x4 pw = *(const u32x4*)(ple + row * 1024 + col);
                        f32x4 p0, p1;
                        p0[0] = __uint_as_float(pw.x << 16); p0[1] = __uint_as_float(pw.x & 0xffff0000u); p0[2] = __uint_as_float(pw.y << 16); p0[3] = __uint_as_float(pw.y & 0xffff0000u);
                        p1[0] = __uint_as_float(pw.z << 16); p1[1] = __uint_as_float(pw.z & 0xffff0000u); p1[2] = __uint_as_float(pw.w << 16); p1[3] = __uint_as_float(pw.w & 0xffff0000u);
                        f32x4 o0, o1;
#pragma unroll
                        for (int e = 0; e < 4; ++e) { o0[e] = h0[e] + p0[e] / (1.f + __expf(-v0[e])); o1[e] = h1[e] + p1[e] / (1.f + __expf(-v1[e])); }
                        *(f32x4*)op = o0; *(f32x4*)(op + 4) = o1;
                    } else {
                        if (MODE == 1) {
#pragma unroll
                            for (int e = 0; e < 4; ++e) { float a = fmaxf(v0[e], 0.f), b = fmaxf(v1[e], 0.f); v0[e] = a * a; v1[e] = b * b; }
                        }
                        u32x4 w; w.x = cvt_pk_bf16(v0[0], v0[1]); w.y = cvt_pk_bf16(v0[2], v0[3]); w.z = cvt_pk_bf16(v1[0], v1[1]); w.w = cvt_pk_bf16(v1[2], v1[3]);
                        *(u32x4*)(O + row * ldc + col) = w;
                    }
                }
            }
    }
};
template <class Epi, class Sched, bool ALIGN_EPI = false, bool SP2 = false>
__device__ __forceinline__ void gemm_phase(PG8_LAS unsigned char* lds, const Gemm g, const Sched& S, const Epi& E) {
    int tid_ = threadIdx.x; asm volatile("" : "+v"(tid_)); const int tid = tid_, wid = __builtin_amdgcn_readfirstlane(tid >> 6), lane = tid & 63, wr = wid >> 2, wc = wid & 3, fr = lane & 15, fq = lane >> 4;
    const int K = g.K, nt = K / BK;
    unsigned voffA[2], voffB[2];
#pragma unroll
    for (int i = 0; i < 2; ++i) { int R, C; stage_rc(tid * 16 + i * 8192, R, C); const int Rb = Epi::PERM ? ((R & ~31) + perm32(R & 31)) : R;
        voffA[i] = (unsigned)(R * K + C) * 2u; voffB[i] = (unsigned)(Rb * K + C) * 2u; }
    const size_t kstep = (size_t)(BK * 2);
    const size_t hstep = (size_t)HALF * K * 2;
    const size_t tstep = 2 * hstep;
    const unsigned ldsw = (unsigned)wid * 1024u;
    const int aoff = lds_byte(wr * 64 + fr, fq * 8), boff = lds_byte(wc * 32 + fr, fq * 8);
#define PG8_SA(b, h) (((b) * 2 + (h)) * HTB)
#define PG8_SB(b, h) ((4 + (b) * 2 + (h)) * HTB)
#define PG8_STAGE(bufoff, gbase, voff) do { _Pragma("unroll") for (int _i = 0; _i < 2; ++_i) \
        __builtin_amdgcn_global_load_lds((const unsigned*)((const char*)(gbase) + (voff)[_i]), (PG8_LAS unsigned*)(lds + (bufoff) + ldsw + _i * 8192), 16, 0, 0); } while (0)
#define PG8_LDA(dst, b, h) do { _Pragma("unroll") for (int m = 0; m < 4; ++m) _Pragma("unroll") for (int k = 0; k < 2; ++k) dst[m][k] = *(const PG8_LAS bf16x8*)(lds + PG8_SA(b, h) + aoff + m * 2048 + k * 1024); } while (0)
#define PG8_LDB(dst, b, h) do { _Pragma("unroll") for (int n = 0; n < 2; ++n) _Pragma("unroll") for (int k = 0; k < 2; ++k) dst[n][k] = *(const PG8_LAS bf16x8*)(lds + PG8_SB(b, h) + boff + n * 2048 + k * 1024); } while (0)
#define PG8_MMA(ai, bj, At, Bt) do { __builtin_amdgcn_s_setprio(1); _Pragma("unroll") for (int m = 0; m < 4; ++m) _Pragma("unroll") for (int n = 0; n < 2; ++n) _Pragma("unroll") for (int k = 0; k < 2; ++k) \
        acc[ai][bj][m][n] = __builtin_amdgcn_mfma_f32_16x16x32_bf16(Bt[n][k], At[m][k], acc[ai][bj][m][n], 0, 0, 0); __builtin_amdgcn_s_setprio(0); } while (0)
#define PG8_WAIT_V(n) asm volatile("s_waitcnt vmcnt(" #n ")" ::: "memory")
#define PG8_WAIT_L(n) asm volatile("s_waitcnt lgkmcnt(" #n ")" ::: "memory")
#define PG8_BAR __builtin_amdgcn_s_barrier()
#define PG8_SCHED __builtin_amdgcn_sched_barrier(0)
    Unit cur, nxt; int ui = 0;
    if (!S.next(0, cur)) return;
    f32x4 acc[2][2][4][2];
#pragma unroll
    for (int a = 0; a < 2; ++a)
#pragma unroll
        for (int b = 0; b < 2; ++b)
#pragma unroll
            for (int m = 0; m < 4; ++m)
#pragma unroll
                for (int n = 0; n < 2; ++n) acc[a][b][m][n] = (f32x4){0.f, 0.f, 0.f, 0.f};
    bf16x8 At[4][2], B0[2][2], B1[2][2];
    const char* cA = (const char*)g.A + (size_t)cur.pm * tstep; const char* cB = (const char*)g.Bt + (size_t)cur.pn * tstep;
    S.a_ready(cur);
    if constexpr (SP2) {
        PG8_STAGE(PG8_SB(0, 0), cB, voffB); PG8_STAGE(PG8_SB(0, 1), cB + hstep, voffB); PG8_STAGE(PG8_SA(0, 0), cA, voffA); PG8_STAGE(PG8_SA(0, 1), cA + hstep, voffA);
        if (wr == 1) PG8_BAR;
        PG8_WAIT_V(2); PG8_BAR;
        PG8_STAGE(PG8_SB(1, 0), cB + kstep, voffB); PG8_STAGE(PG8_SA(1, 0), cA + kstep, voffA); PG8_STAGE(PG8_SB(1, 1), cB + hstep + kstep, voffB);
        PG8_WAIT_V(6); PG8_BAR;
    } else {
        PG8_STAGE(PG8_SB(0, 0), cB, voffB); PG8_STAGE(PG8_SA(0, 0), cA, voffA); PG8_STAGE(PG8_SB(0, 1), cB + hstep, voffB); PG8_STAGE(PG8_SA(0, 1), cA + hstep, voffA);
        if (wr == 1) PG8_BAR;
        PG8_WAIT_V(4); PG8_BAR;
        PG8_STAGE(PG8_SB(1, 0), cB + kstep, voffB); PG8_STAGE(PG8_SA(1, 0), cA + kstep, voffA); PG8_STAGE(PG8_SB(1, 1), cB + hstep + kstep, voffB);
        PG8_WAIT_V(6); PG8_BAR;
    }
    for (;;) {
        const bool has_next = S.next(ui + 1, nxt);
        const char* nA = has_next ? (const char*)g.A + (size_t)nxt.pm * tstep : cA; const char* nB = has_next ? (const char*)g.Bt + (size_t)nxt.pn * tstep : cB;
        for (int t = 0; t < nt; t += 2) {
            const bool last = (t == nt - 2);
            const char* a1 = cA + (size_t)(t + 1) * kstep;
            const char* a2 = last ? nA : cA + (size_t)(t + 2) * kstep; const char* b2 = last ? nB : cB + (size_t)(t + 2) * kstep;
            const char* a3 = a2 + kstep; const char* b3 = b2 + kstep;
            if (last && has_next) S.a_ready(nxt);
            if constexpr (SP2) {
            PG8_LDB(B0, 0, 0); PG8_LDB(B1, 0, 1); PG8_SCHED; PG8_LDA(At, 0, 0); PG8_STAGE(PG8_SA(1, 1), a1 + hstep, voffA);
            PG8_WAIT_V(8); PG8_WAIT_L(0); PG8_BAR; PG8_MMA(0, 0, At, B0); PG8_MMA(0, 1, At, B1); PG8_BAR; PG8_SCHED;
            PG8_LDA(At, 0, 1); PG8_STAGE(PG8_SB(0, 0), b2, voffB); PG8_STAGE(PG8_SB(0, 1), b2 + hstep, voffB); PG8_STAGE(PG8_SA(0, 0), a2, voffA);
            PG8_WAIT_V(8); PG8_WAIT_L(0); PG8_BAR; PG8_MMA(1, 0, At, B0); PG8_MMA(1, 1, At, B1); PG8_BAR; PG8_SCHED;
            PG8_LDB(B0, 1, 0); PG8_LDB(B1, 1, 1); PG8_SCHED; PG8_LDA(At, 1, 0); PG8_STAGE(PG8_SA(0, 1), a2 + hstep, voffA);
            PG8_WAIT_V(8); PG8_WAIT_L(0); PG8_BAR; PG8_MMA(0, 0, At, B0); PG8_MMA(0, 1, At, B1); PG8_BAR; PG8_SCHED;
            PG8_LDA(At, 1, 1); PG8_STAGE(PG8_SB(1, 0), b3, voffB); PG8_STAGE(PG8_SB(1, 1), b3 + hstep, voffB); PG8_STAGE(PG8_SA(1, 0), a3, voffA);
            PG8_WAIT_V(8); PG8_WAIT_L(0); PG8_BAR; PG8_MMA(1, 0, At, B0); PG8_MMA(1, 1, At, B1); PG8_BAR; PG8_SCHED;
            } else {
            PG8_LDB(B0, 0, 0); PG8_SCHED; PG8_LDA(At, 0, 0); PG8_STAGE(PG8_SA(1, 1), a1 + hstep, voffA);
            PG8_WAIT_L(8); PG8_BAR; PG8_WAIT_L(0); PG8_MMA(0, 0, At, B0); PG8_BAR; PG8_SCHED;
            PG8_LDB(B1, 0, 1); PG8_STAGE(PG8_SB(0, 0), b2, voffB);
            PG8_BAR; PG8_WAIT_L(0); PG8_MMA(0, 1, At, B1); PG8_BAR;
            PG8_LDA(At, 0, 1); PG8_STAGE(PG8_SA(0, 0), a2, voffA);
            PG8_BAR; PG8_WAIT_L(0); PG8_MMA(1, 0, At, B0); PG8_BAR; PG8_SCHED;
            PG8_STAGE(PG8_SB(0, 1), b2 + hstep, voffB);
            PG8_WAIT_V(6); PG8_BAR; PG8_MMA(1, 1, At, B1); PG8_BAR;
            PG8_LDB(B0, 1, 0); PG8_SCHED; PG8_LDA(At, 1, 0); PG8_STAGE(PG8_SA(0, 1), a2 + hstep, voffA);
            PG8_WAIT_L(8); PG8_BAR; PG8_WAIT_L(0); PG8_MMA(0, 0, At, B0); PG8_BAR; PG8_SCHED;
            PG8_LDB(B1, 1, 1); PG8_STAGE(PG8_SB(1, 0), b3, voffB);
            PG8_BAR; PG8_WAIT_L(0); PG8_MMA(0, 1, At, B1); PG8_BAR;
            PG8_LDA(At, 1, 1); PG8_STAGE(PG8_SA(1, 0), a3, voffA);
            PG8_BAR; PG8_WAIT_L(0); PG8_MMA(1, 0, At, B0); PG8_BAR; PG8_SCHED;
            PG8_STAGE(PG8_SB(1, 1), b3 + hstep, voffB);
            PG8_WAIT_V(6); PG8_BAR; PG8_MMA(1, 1, At, B1); PG8_BAR;
            }
        }
        if constexpr (ALIGN_EPI) { if (wr == 0) PG8_BAR; }
        if constexpr (!Epi::AFTER_DRAIN) { E(acc, cur, wr, wc, fr, fq); S.done(cur); }
        if (!has_next) break;
#pragma unroll
        for (int a = 0; a < 2; ++a)
#pragma unroll
            for (int b = 0; b < 2; ++b)
#pragma unroll
                for (int m = 0; m < 4; ++m)
#pragma unroll
                    for (int n = 0; n < 2; ++n) acc[a][b][m][n] = (f32x4){0.f, 0.f, 0.f, 0.f};
        cur = nxt; cA = nA; cB = nB; ++ui;
        if constexpr (ALIGN_EPI) { if (wr == 1) PG8_BAR; }
    }
    PG8_WAIT_V(0);
    if constexpr (!ALIGN_EPI) { if (wr == 0) PG8_BAR; }
    PG8_BAR;
    if constexpr (Epi::AFTER_DRAIN) { E.fused(acc, cur, wr, wc, fr, fq, lds, wid, lane); S.done(cur); }
#undef PG8_SA
#undef PG8_SB
#undef PG8_STAGE
#undef PG8_LDA
#undef PG8_LDB
#undef PG8_MMA
#undef PG8_WAIT_V
#undef PG8_WAIT_L
#undef PG8_BAR
#undef PG8_SCHED
}
}
typedef pg8::bf16_t bf16_t;
typedef pg8::bf16x8 bf16x8;
typedef pg8::f32x4 f32x4;
typedef pg8::u32x4 u32x4;
typedef unsigned u32x2 __attribute__((ext_vector_type(2)));
#define LAS __attribute__((address_space(3)))
constexpr int MTOK = 32768, DM = 1024, SEQ = 2048, NPROJ = 3584, DFF = 4096, PLED = 256, LDWIN = 3592;
constexpr int C_GQ = 0, C_GK = 512, C_GV = 1024, C_GZ = 1536, C_MQ = 2048, C_MK = 2560, C_MV = 3072;
constexpr float RMS_EPS = 1e-6f;
constexpr int LDS_BYTES = 143360;
constexpr size_t WS_WIN = 4096, WS_WOUT = WS_WIN + (size_t)NPROJ * DM * 2, WS_WUP = WS_WOUT + (size_t)DM * DM * 2, WS_WDOWN = WS_WUP + (size_t)DFF * DM * 2,
    WS_WGATE = WS_WDOWN + (size_t)DFF * DM * 2, WS_WPLE = WS_WGATE + (size_t)DM * DM * 2, WS_ROPE = WS_WPLE + (size_t)DM * PLED * 2, WS_LG = WS_ROPE + (size_t)SEQ * 32 * 4,
    WS_KMEAN = WS_LG + (size_t)MTOK * 8 * 4, WS_PB = WS_KMEAN + (size_t)64 * 8 * 128 * 4, WS_U = WS_PB + (size_t)MTOK * PLED * 2, WS_VT = WS_U + (size_t)MTOK * DM * 2,
    WS_MIXIN = WS_VT + (size_t)64 * 128 * SEQ * 2, WS_BIG = WS_MIXIN + (size_t)MTOK * DM * 2, WS_END = WS_BIG + (size_t)MTOK * DFF * 2;

struct Params {
    const float *x, *p, *w_in, *conv_w, *a_log, *dt_bias, *gdn_norm_w, *w_out, *n_pre_attn, *n_post_attn, *n_pre_mlp, *n_post_mlp, *w_up, *w_down, *w_ple, *w_gate;
    float* out; unsigned char* ws;
    float inv_freq[16];
};

__device__ __forceinline__ float wave_sum(float v) {
#pragma unroll
    for (int o = 1; o < 64; o <<= 1) v += __shfl_xor(v, o);
    return v;
}
__device__ __forceinline__ float bflo(unsigned w) { return __uint_as_float(w << 16); }
__device__ __forceinline__ float bfhi(unsigned w) { return __uint_as_float(w & 0xffff0000u); }
__device__ __forceinline__ unsigned pk2(float lo, float hi) { return pg8::cvt_pk_bf16(lo, hi); }
__device__ __forceinline__ float silu_f(float v) { return v / (1.f + __expf(-v)); }

__device__ __forceinline__ void transpose_item(const float* W, int ldw, int K, int k0, int srccol0, bf16_t* WT, int n0, float* scr, int lane) {
#pragma unroll 8
    for (int i = 0; i < 32; ++i) { const int kk = 2 * i + (lane >> 5); scr[kk * 33 + (lane & 31)] = W[(size_t)(k0 + kk) * ldw + srccol0 + (lane & 31)]; }
    __builtin_amdgcn_s_waitcnt(0xc07f); asm volatile("s_waitcnt lgkmcnt(0)" ::: "memory");
    const int c = lane & 7;
#pragma unroll
    for (int j = 0; j < 4; ++j) { const int n = (lane >> 3) + 8 * j; const float* s = scr + (8 * c) * 33 + n;
        u32x4 o; o.x = pk2(s[0 * 33], s[1 * 33]); o.y = pk2(s[2 * 33], s[3 * 33]); o.z = pk2(s[4 * 33], s[5 * 33]); o.w = pk2(s[6 * 33], s[7 * 33]);
        *(u32x4*)(WT + (size_t)(n0 + n) * K + k0 + 8 * c) = o; }
    asm volatile("s_waitcnt lgkmcnt(0)" ::: "memory");
}
__device__ __forceinline__ void transpose_matrix(const float* W, int ldw, int K, int N, bool is_win, bf16_t* WT, float* scr, int gw, int NGW, int lane) {
    const int nblk = N / 32, items = (K / 64) * nblk;
    for (int it = gw; it < items; it += NGW) { const int kb = it / nblk, nb = it % nblk; const int n0 = nb * 32; const int src = is_win ? (n0 >= 2048 ? n0 + 8 : n0) : n0;
        transpose_item(W, ldw, K, kb * 64, src, WT, n0, scr, lane); }
}
__device__ __forceinline__ void phase0(const Params& P, unsigned char* smem) {
    const int tid = threadIdx.x, lane = tid & 63, wave = tid >> 6; const int G = gridDim.x; const int gw = blockIdx.x * 8 + wave, NGW = G * 8;
    unsigned char* ws = P.ws;
    float* scr = (float*)(smem + 32768) + wave * (64 * 33);
    float* wl = (float*)smem;
    for (int i = tid; i < 1024 * 8; i += 512) wl[i] = P.w_in[(size_t)(i >> 3) * LDWIN + 2048 + (i & 7)];
    transpose_matrix(P.w_in, LDWIN, DM, NPROJ, true, (bf16_t*)(ws + WS_WIN), scr, gw, NGW, lane);
    transpose_matrix(P.w_out, DM, DM, DM, false, (bf16_t*)(ws + WS_WOUT), scr, gw, NGW, lane);
    transpose_matrix(P.w_up, DFF, DM, DFF, false, (bf16_t*)(ws + WS_WUP), scr, gw, NGW, lane);
    transpose_matrix(P.w_down, DM, DFF, DM, false, (bf16_t*)(ws + WS_WDOWN), scr, gw, NGW, lane);
    transpose_matrix(P.w_gate, DM, DM, DM, false, (bf16_t*)(ws + WS_WGATE), scr, gw, NGW, lane);
    transpose_matrix(P.w_ple, DM, PLED, DM, false, (bf16_t*)(ws + WS_WPLE), scr, gw, NGW, lane);
    { float* rope = (float*)(ws + WS_ROPE);
      for (int i = blockIdx.x * 512 + tid; i < SEQ * 16; i += G * 512) { const int t = i >> 4, d = i & 15; const float ang = (float)t * P.inv_freq[d];
          double rev = (double)ang * 0.15915494309189533577; rev -= __builtin_rint(rev); const float fr = (float)rev;
          rope[t * 32 + d] = __builtin_amdgcn_cosf(fr); rope[t * 32 + 16 + d] = __builtin_amdgcn_sinf(fr); } }
    { bf16_t* pb = (bf16_t*)(ws + WS_PB); const size_t n8 = (size_t)MTOK * PLED / 8;
      for (size_t i = (size_t)blockIdx.x * 512 + tid; i < n8; i += (size_t)G * 512) { const f32x4 a = *(const f32x4*)(P.p + i * 8), b = *(const f32x4*)(P.p + i * 8 + 4);
          u32x4 o; o.x = pk2(a[0], a[1]); o.y = pk2(a[2], a[3]); o.z = pk2(b[0], b[1]); o.w = pk2(b[2], b[3]); *(u32x4*)(pb + i * 8) = o; } }
    __syncthreads();
    { bf16_t* U = (bf16_t*)(ws + WS_U); float* LG = (float*)(ws + WS_LG);
      f32x4 wn[4];
#pragma unroll
      for (int j = 0; j < 4; ++j) wn[j] = *((const f32x4*)P.n_pre_attn + lane + 64 * j);
      for (int m = gw; m < MTOK; m += NGW) {
          const f32x4* xr = (const f32x4*)(P.x + (size_t)m * DM) + lane; f32x4 v[4]; float s = 0.f;
#pragma unroll
          for (int j = 0; j < 4; ++j) { v[j] = xr[64 * j]; s += (v[j][0] * v[j][0] + v[j][1] * v[j][1]) + (v[j][2] * v[j][2] + v[j][3] * v[j][3]); }
          const float rstd = rsqrtf(wave_sum(s) * (1.f / DM) + RMS_EPS);
          float lg[8];
#pragma unroll
          for (int c = 0; c < 8; ++c) lg[c] = 0.f;
#pragma unroll
          for (int j = 0; j < 4; ++j) { v[j] = v[j] * rstd * wn[j];
              u32x2 o; o.x = pk2(v[j][0], v[j][1]); o.y = pk2(v[j][2], v[j][3]); *(u32x2*)(U + (size_t)m * DM + 4 * lane + 256 * j) = o;
#pragma unroll
              for (int e = 0; e < 4; ++e) { const f32x4 w0 = *(const f32x4*)(wl + (4 * lane + 256 * j + e) * 8), w1 = *(const f32x4*)(wl + (4 * lane + 256 * j + e) * 8 + 4);
#pragma unroll
                  for (int c = 0; c < 4; ++c) { lg[c] += v[j][e] * w0[c]; lg[4 + c] += v[j][e] * w1[c]; } } }
#pragma unroll
          for (int c = 0; c < 8; ++c) lg[c] = wave_sum(lg[c]);
          if (lane == 0) { *(f32x4*)(LG + (size_t)m * 8) = (f32x4){lg[0], lg[1], lg[2], lg[3]}; *(f32x4*)(LG + (size_t)m * 8 + 4) = (f32x4){lg[4], lg[5], lg[6], lg[7]}; }
      } }
}

__device__ __forceinline__ void moba_prep(const Params& P, unsigned char* smem) {
    const int tid = threadIdx.x; unsigned char* ws = P.ws;
    bf16_t* PROJ = (bf16_t*)(ws + WS_BIG); const float* rope = (const float*)(ws + WS_ROPE); float* KMEAN = (float*)(ws + WS_KMEAN); bf16_t* VT = (bf16_t*)(ws + WS_VT);
    unsigned char* vt = smem;
    float* red = (float*)(smem + 69632);
    const int p = tid & 15, r = tid >> 4;
    for (int unit = blockIdx.x; unit < 512; unit += gridDim.x) {
        const int bh = unit >> 3, n = unit & 7, b = bh >> 2, h = bh & 3; const int m0 = b * SEQ + n * 256;
        float ksum[8];
#pragma unroll
        for (int e = 0; e < 8; ++e) ksum[e] = 0.f;
        for (int i = 0; i < 8; ++i) { const int row = r + 32 * i, t = n * 256 + row; const size_t m = (size_t)(m0 + row);
#pragma unroll
            for (int ten = 0; ten < 2; ++ten) {
                bf16_t* ptr = PROJ + m * NPROJ + (ten == 0 ? C_MQ : C_MK) + h * 128 + 8 * p;
                const u32x4 w = *(const u32x4*)ptr; u32x4 o; o.x = __shfl_xor(w.x, 2); o.y = __shfl_xor(w.y, 2); o.z = __shfl_xor(w.z, 2); o.w = __shfl_xor(w.w, 2);
                float a[8] = {bflo(w.x), bfhi(w.x), bflo(w.y), bfhi(w.y), bflo(w.z), bfhi(w.z), bflo(w.w), bfhi(w.w)};
                if (p < 4) {
                    const float bb[8] = {bflo(o.x), bfhi(o.x), bflo(o.y), bfhi(o.y), bflo(o.z), bfhi(o.z), bflo(o.w), bfhi(o.w)};
                    const float* cs = rope + t * 32 + 8 * (p & 1);
                    const f32x4 c0 = *(const f32x4*)cs, c1 = *(const f32x4*)(cs + 4), s0 = *(const f32x4*)(cs + 16), s1 = *(const f32x4*)(cs + 20);
                    const float cc[8] = {c0[0], c0[1], c0[2], c0[3], c1[0], c1[1], c1[2], c1[3]}, ss[8] = {s0[0], s0[1], s0[2], s0[3], s1[0], s1[1], s1[2], s1[3]};
#pragma unroll
                    for (int e = 0; e < 8; ++e) a[e] = (p < 2) ? (a[e] * cc[e] - bb[e] * ss[e]) : (a[e] * cc[e] + bb[e] * ss[e]);
                    u32x4 st; st.x = pk2(a[0], a[1]); st.y = pk2(a[2], a[3]); st.z = pk2(a[4], a[5]); st.w = pk2(a[6], a[7]);
                    *(u32x4*)ptr = st;
                }
                if (ten == 1) {
#pragma unroll
                    for (int e = 0; e < 8; ++e) ksum[e] += a[e];
                }
            }
            const u32x4 vv = *(const u32x4*)(PROJ + m * NPROJ + C_MV + h * 128 + 8 * p);
            *(u32x4*)(vt + row * 272 + 16 * p) = vv;
        }
#pragma unroll
        for (int e = 0; e < 8; ++e) red[r * 128 + 8 * p + e] = ksum[e];
        __syncthreads();
        if (tid < 128) { float s = 0.f; for (int q = 0; q < 32; ++q) s += red[q * 128 + tid]; KMEAN[((size_t)bh * 8 + n) * 128 + tid] = s * (1.f / 256.f); }
        { const int d = tid & 127, tg = tid >> 7;
          for (int gi = 0; gi < 8; ++gi) { const int g = tg * 8 + gi, s32 = g >> 2, fq = g & 3; unsigned short e8[8];
#pragma unroll
              for (int j = 0; j < 8; ++j) { const int tok = 32 * s32 + (j < 4 ? 4 * fq + j : 16 + 4 * fq + (j - 4)); e8[j] = *(const unsigned short*)(vt + tok * 272 + 2 * d); }
              u32x4 o; o.x = e8[0] | ((unsigned)e8[1] << 16); o.y = e8[2] | ((unsigned)e8[3] << 16); o.z = e8[4] | ((unsigned)e8[5] << 16); o.w = e8[6] | ((unsigned)e8[7] << 16);
              *(u32x4*)(VT + ((size_t)bh * 128 + d) * SEQ + n * 256 + 8 * g) = o; } }
        __syncthreads();
    }
}

__device__ __forceinline__ void moba_unit(const Params& P, unsigned char* smem, int bh, int qb) {
    int tid_ = threadIdx.x; asm volatile("" : "+v"(tid_)); const int tid = tid_, lane = tid & 63, w = tid >> 6, fr = lane & 15, fq = lane >> 4; const int b = bh >> 2, h = bh & 3;
    unsigned char* ws = P.ws;
    const bf16_t* PROJ = (const bf16_t*)(ws + WS_BIG); const float* KMEAN = (const float*)(ws + WS_KMEAN); const bf16_t* VT = (const bf16_t*)(ws + WS_VT); bf16_t* MIXIN = (bf16_t*)(ws + WS_MIXIN);
    const int qrow0 = qb * 256 + 32 * w;
    bf16x8 qf[2][4];
#pragma unroll
    for (int rt = 0; rt < 2; ++rt)
#pragma unroll
        for (int ks = 0; ks < 4; ++ks) qf[rt][ks] = *(const bf16x8*)(PROJ + (size_t)(b * SEQ + qrow0 + 16 * rt + fr) * NPROJ + C_MQ + h * 128 + 32 * ks + 8 * fq);
    unsigned selmask[2];
    if (qb <= 3) { selmask[0] = selmask[1] = (1u << qb) - 1u; }
    else {
        bf16x8 kmf[4];
#pragma unroll
        for (int ks = 0; ks < 4; ++ks) { const float* src = KMEAN + ((size_t)bh * 8 + (fr & 7)) * 128 + 32 * ks + 8 * fq; const f32x4 a = *(const f32x4*)src, c = *(const f32x4*)(src + 4);
            u32x4 o; o.x = pk2(a[0], a[1]); o.y = pk2(a[2], a[3]); o.z = pk2(c[0], c[1]); o.w = pk2(c[2], c[3]); if (fr >= 8) o = (u32x4){0u, 0u, 0u, 0u};
            kmf[ks] = __builtin_bit_cast(bf16x8, o); }
#pragma unroll
        for (int rt = 0; rt < 2; ++rt) { f32x4 g = {0.f, 0.f, 0.f, 0.f};
#pragma unroll
            for (int ks = 0; ks < 4; ++ks) g = __builtin_amdgcn_mfma_f32_16x16x32_bf16(kmf[ks], qf[rt][ks], g, 0, 0, 0);
            float gv[8];
#pragma unroll
            for (int i = 0; i < 4; ++i) { gv[i] = __shfl(g[i], fr); gv[4 + i] = __shfl(g[i], 16 + fr); }
            unsigned msk = 0u;
#pragma unroll
            for (int rep = 0; rep < 3; ++rep) { float best = -INFINITY; int bi = 0;
#pragma unroll
                for (int n = 0; n < 8; ++n) { const bool ok = (n < qb) && !((msk >> n) & 1u) && (gv[n] > best); best = ok ? gv[n] : best; bi = ok ? n : bi; }
                msk |= 1u << bi; }
            selmask[rt] = msk; }
    }
    f32x4 O[2][8]; float mrun[2], lsum[2];
#pragma unroll
    for (int rt = 0; rt < 2; ++rt) { mrun[rt] = -INFINITY; lsum[rt] = 0.f;
#pragma unroll
        for (int dt = 0; dt < 8; ++dt) O[rt][dt] = (f32x4){0.f, 0.f, 0.f, 0.f}; }
    const int ntiles = (qb + 1) * 4;
    const int krow0 = tid >> 4, kpc = tid & 15;
    const int vrow0 = tid >> 3, vpc = tid & 7;
    const bf16_t* kbase = PROJ + (size_t)(b * SEQ) * NPROJ + C_MK + h * 128 + 8 * kpc;
    const bf16_t* vbase = VT + (size_t)bh * 128 * SEQ + 8 * vpc;
    u32x4 st[4];
#define MOBA_LOAD(key0) do { st[0] = *(const u32x4*)(kbase + (size_t)((key0) + krow0) * NPROJ); st[1] = *(const u32x4*)(kbase + (size_t)((key0) + krow0 + 32) * NPROJ); \
        st[2] = *(const u32x4*)(vbase + (size_t)vrow0 * SEQ + (key0)); st[3] = *(const u32x4*)(vbase + (size_t)(vrow0 + 64) * SEQ + (key0)); } while (0)
#define MOBA_STORE(buf) do { unsigned char* kb_ = smem + (buf) * 35840; unsigned char* vb_ = kb_ + 17408; \
        *(u32x4*)(kb_ + krow0 * 272 + kpc * 16) = st[0]; *(u32x4*)(kb_ + (krow0 + 32) * 272 + kpc * 16) = st[1]; \
        *(u32x4*)(vb_ + vrow0 * 144 + vpc * 16) = st[2]; *(u32x4*)(vb_ + (vrow0 + 64) * 144 + vpc * 16) = st[3]; } while (0)
    MOBA_LOAD(0); MOBA_STORE(0);
    __syncthreads();
    const float SC = 0.08838834764831845f * 1.4426950408889634f;
    for (int tt = 0; tt < ntiles; ++tt) {
        const int n = tt >> 2, key0 = tt * 64; const int buf = tt & 1;
        if (tt + 1 < ntiles) MOBA_LOAD(key0 + 64);
        const unsigned char* kb = smem + buf * 35840; const unsigned char* vb = kb + 17408;
        f32x4 s[2][4];
#pragma unroll
        for (int rt = 0; rt < 2; ++rt)
#pragma unroll
            for (int kt = 0; kt < 4; ++kt) s[rt][kt] = (f32x4){0.f, 0.f, 0.f, 0.f};
#pragma unroll
        for (int kt = 0; kt < 4; ++kt)
#pragma unroll
            for (int ks = 0; ks < 4; ++ks) { const bf16x8 kf = *(const bf16x8*)(kb + (16 * kt + fr) * 272 + (32 * ks + 8 * fq) * 2);
                s[0][kt] = __builtin_amdgcn_mfma_f32_16x16x32_bf16(kf, qf[0][ks], s[0][kt], 0, 0, 0);
                s[1][kt] = __builtin_amdgcn_mfma_f32_16x16x32_bf16(kf, qf[1][ks], s[1][kt], 0, 0, 0);
                if (ks == 3) __builtin_amdgcn_sched_barrier(0); }
        bf16x8 pf[2][2];
#pragma unroll
        for (int rt = 0; rt < 2; ++rt) {
            const int row_t = qrow0 + 16 * rt + fr;
            const bool rowsel = (n < qb) ? (((selmask[rt] >> n) & 1u) != 0u) : true;
            float mx = -INFINITY;
#pragma unroll
            for (int kt = 0; kt < 4; ++kt)
#pragma unroll
                for (int i = 0; i < 4; ++i) { float v = s[rt][kt][i] * SC; const int key = key0 + 16 * kt + 4 * fq + i;
                    if (!rowsel || (n == qb && key > row_t)) v = -INFINITY; s[rt][kt][i] = v; mx = fmaxf(mx, v); }
            mx = fmaxf(mx, __shfl_xor(mx, 16)); mx = fmaxf(mx, __shfl_xor(mx, 32));
            const float mnew = fmaxf(mrun[rt], mx), muse = (mnew == -INFINITY) ? 0.f : mnew;
            const float alpha = exp2f(mrun[rt] - muse); mrun[rt] = mnew;
            float ps = 0.f;
#pragma unroll
            for (int kt = 0; kt < 4; ++kt)
#pragma unroll
                for (int i = 0; i < 4; ++i) { const float pv = exp2f(s[rt][kt][i] - muse); s[rt][kt][i] = pv; ps += pv; }
            lsum[rt] = lsum[rt] * alpha + ps;
#pragma unroll
            for (int sl = 0; sl < 2; ++sl) { u32x4 o; o.x = pk2(s[rt][2 * sl][0], s[rt][2 * sl][1]); o.y = pk2(s[rt][2 * sl][2], s[rt][2 * sl][3]);
                o.z = pk2(s[rt][2 * sl + 1][0], s[rt][2 * sl + 1][1]); o.w = pk2(s[rt][2 * sl + 1][2], s[rt][2 * sl + 1][3]); pf[rt][sl] = __builtin_bit_cast(bf16x8, o); }
#pragma unroll
            for (int dt = 0; dt < 8; ++dt) O[rt][dt] = O[rt][dt] * alpha;
        }
#pragma unroll
        for (int sl = 0; sl < 2; ++sl)
#pragma unroll
            for (int dt = 0; dt < 8; ++dt) { const bf16x8 vf = *(const bf16x8*)(vb + (16 * dt + fr) * 144 + (32 * sl + 8 * fq) * 2);
                O[0][dt] = __builtin_amdgcn_mfma_f32_16x16x32_bf16(vf, pf[0][sl], O[0][dt], 0, 0, 0);
                O[1][dt] = __builtin_amdgcn_mfma_f32_16x16x32_bf16(vf, pf[1][sl], O[1][dt], 0, 0, 0);
                if ((dt & 3) == 3) __builtin_amdgcn_sched_barrier(0); }
        if (tt + 1 < ntiles) MOBA_STORE(buf ^ 1);
        __syncthreads();
    }
#undef MOBA_LOAD
#undef MOBA_STORE
#pragma unroll
    for (int rt = 0; rt < 2; ++rt) { float l = lsum[rt]; l += __shfl_xor(l, 16); l += __shfl_xor(l, 32); const float inv = 1.f / l;
        bf16_t* orow = MIXIN + (size_t)(b * SEQ + qrow0 + 16 * rt + fr) * DM + 512 + h * 128 + 4 * fq;
#pragma unroll
        for (int dt = 0; dt < 8; ++dt) { u32x2 o; o.x = pk2(O[rt][dt][0] * inv, O[rt][dt][1] * inv); o.y = pk2(O[rt][dt][2] * inv, O[rt][dt][3] * inv); *(u32x2*)(orow + 16 * dt) = o; } }
}

constexpr size_t WS_LBUF = WS_U, WS_GLAST = WS_END, WS_BVT = WS_END + 8192;
constexpr size_t WS_END2 = WS_BVT + (size_t)2048 * 16384;
__device__ __forceinline__ unsigned bf1(float v) { return pk2(v, 0.f) & 0xffffu; }

__device__ __forceinline__ void gdn_prep(const Params& P, unsigned char* smem) {
    int tid_ = threadIdx.x; asm volatile("" : "+v"(tid_)); const int tid = tid_, lane = tid & 63, wave = tid >> 6, fr = lane & 15, fq = lane >> 4; unsigned char* ws = P.ws;
    const bf16_t* PROJ = (const bf16_t*)(ws + WS_BIG); const float* LG = (const float*)(ws + WS_LG); unsigned char* REC = (unsigned char*)P.out;
    float* LB = (float*)(ws + WS_LBUF); bf16_t* BVT = (bf16_t*)(ws + WS_BVT); float* GLAST = (float*)(ws + WS_GLAST);
    float* Ks = (float*)smem; float* Vs = (float*)(smem + 32768); unsigned char* Kb = smem + 65536; unsigned char* Qb = smem + 82944;
    float* gs = (float*)(smem + 100352); float* bs = gs + 64; float* es = bs + 64; float* eg = es + 64;
    const int p = tid & 15, rr = tid >> 4; const int G = gridDim.x;
    for (int chunk = blockIdx.x; chunk < 2048; chunk += G) {
        const int bh = chunk >> 5, n = chunk & 31, b = bh >> 2, h = bh & 3, t0 = n * 64;
        unsigned char* rec = REC + (size_t)chunk * 65536;
        if (wave == 0) { const size_t m = (size_t)(b * SEQ + t0 + lane); const float gb = LG[m * 8 + h], ga = LG[m * 8 + 4 + h] + P.dt_bias[h];
            const float beta = 1.f / (1.f + __expf(-gb)); const float sp = ga > 20.f ? ga : log1pf(__expf(ga)); float g = -__expf(P.a_log[h]) * sp;
#pragma unroll
            for (int o = 1; o < 64; o <<= 1) { const float v = __shfl_up(g, o); if (lane >= o) g += v; }
            const float g63 = __shfl(g, 63);
            gs[lane] = g; bs[lane] = beta; es[lane] = __expf(g63 - g); eg[lane] = __expf(g);
            if (lane == 63) GLAST[chunk] = __expf(g); }
        __syncthreads();
        for (int half = 0; half < 2; ++half) { const int row = rr + 32 * half, t = t0 + row; const float egr = eg[row], br = bs[row];
#pragma unroll
            for (int ten = 0; ten < 3; ++ten) { const int ch = ten * 512 + h * 128 + 8 * p; float acc[8];
#pragma unroll
                for (int e = 0; e < 8; ++e) acc[e] = 0.f;
#pragma unroll
                for (int tap = 0; tap < 4; ++tap) { const int tt = t - 3 + tap;
                    if (tt >= 0) { const u32x4 w = *(const u32x4*)(PROJ + (size_t)(b * SEQ + tt) * NPROJ + ch);
                        const f32x4 w0 = *(const f32x4*)(P.conv_w + tap * 1536 + ch), w1 = *(const f32x4*)(P.conv_w + tap * 1536 + ch + 4);
                        acc[0] += w0[0] * bflo(w.x); acc[1] += w0[1] * bfhi(w.x); acc[2] += w0[2] * bflo(w.y); acc[3] += w0[3] * bfhi(w.y);
                        acc[4] += w1[0] * bflo(w.z); acc[5] += w1[1] * bfhi(w.z); acc[6] += w1[2] * bflo(w.w); acc[7] += w1[3] * bfhi(w.w); } }
                float ss = 0.f;
#pragma unroll
                for (int e = 0; e < 8; ++e) { acc[e] = silu_f(acc[e]); ss += acc[e] * acc[e]; }
                if (ten < 2) { ss += __shfl_xor(ss, 1); ss += __shfl_xor(ss, 2); ss += __shfl_xor(ss, 4); ss += __shfl_xor(ss, 8);
                    const float sc = rsqrtf(ss + RMS_EPS) * (ten == 0 ? 0.08838834764831845f : 1.f);
#pragma unroll
                    for (int e = 0; e < 8; ++e) acc[e] *= sc;
                    u32x4 o; o.x = pk2(acc[0], acc[1]); o.y = pk2(acc[2], acc[3]); o.z = pk2(acc[4], acc[5]); o.w = pk2(acc[6], acc[7]);
                    *(u32x4*)((ten == 0 ? Qb : Kb) + row * 272 + 16 * p) = o;
                    const float f = (ten == 0) ? egr : egr * br;
                    const int pp = p & 3, s1 = 16 * (pp & 1) + 4 * (pp >> 1);
                    unsigned char* rp = rec + (ten == 0 ? 16384 : 0) + row * 256 + (32 * (p >> 2)) * 2;
                    u32x2 a0, a1; a0.x = pk2(acc[0] * f, acc[1] * f); a0.y = pk2(acc[2] * f, acc[3] * f); a1.x = pk2(acc[4] * f, acc[5] * f); a1.y = pk2(acc[6] * f, acc[7] * f);
                    *(u32x2*)(rp + s1 * 2) = a0; *(u32x2*)(rp + (s1 + 8) * 2) = a1; }
                if (ten >= 1) { float* dst = (ten == 1 ? Ks : Vs) + row * 128 + 8 * p;
                    *(f32x4*)dst = (f32x4){acc[0], acc[1], acc[2], acc[3]}; *(f32x4*)(dst + 4) = (f32x4){acc[4], acc[5], acc[6], acc[7]}; } } }
        __syncthreads();
        { const int dcol = tid & 127, gp = tid >> 7;
#pragma unroll
          for (int q = 0; q < 2; ++q) { const int sg = gp * 2 + q, mp = sg >> 2, f4 = sg & 3; float kv[8], vv[8];
#pragma unroll
              for (int jj = 0; jj < 8; ++jj) { const int c = 32 * mp + (jj < 4 ? 4 * f4 + jj : 16 + 4 * f4 + jj - 4); kv[jj] = es[c] * Ks[c * 128 + dcol]; const int s = 8 * sg + jj; vv[jj] = bs[s] * Vs[s * 128 + dcol]; }
              u32x4 o; o.x = pk2(kv[0], kv[1]); o.y = pk2(kv[2], kv[3]); o.z = pk2(kv[4], kv[5]); o.w = pk2(kv[6], kv[7]);
              *(u32x4*)(rec + 32768 + dcol * 128 + sg * 16) = o;
              u32x4 o2; o2.x = pk2(vv[0], vv[1]); o2.y = pk2(vv[2], vv[3]); o2.z = pk2(vv[4], vv[5]); o2.w = pk2(vv[6], vv[7]);
              *(u32x4*)((unsigned char*)BVT + (size_t)chunk * 16384 + dcol * 128 + sg * 16) = o2; } }
        for (int job = wave; job < 26; job += 8) {
            if (job >= 20) { const int u = job - 20; const int it = (u < 3) ? 0 : (u < 5 ? 1 : 2); const int jt = (u < 3) ? u + 1 : (u < 5 ? u - 1 : 3);
                const int i = 16 * it + fr; *(u32x2*)(rec + 57344 + i * 128 + (32 * (jt >> 1) + 8 * fq + 4 * (jt & 1)) * 2) = (u32x2){0u, 0u}; continue; }
            const int idx = job % 10; const bool isL = job < 10;
            const int it = (idx >= 6) ? 3 : (idx >= 3 ? 2 : (idx >= 1 ? 1 : 0)); const int jt = idx - it * (it + 1) / 2;
            const unsigned char* Xb = isL ? Kb : Qb;
            f32x4 d = {0.f, 0.f, 0.f, 0.f};
#pragma unroll
            for (int ks = 0; ks < 4; ++ks) { const bf16x8 kf = *(const bf16x8*)(Kb + (16 * jt + fr) * 272 + (32 * ks + 8 * fq) * 2), xf = *(const bf16x8*)(Xb + (16 * it + fr) * 272 + (32 * ks + 8 * fq) * 2);
                d = __builtin_amdgcn_mfma_f32_16x16x32_bf16(kf, xf, d, 0, 0, 0); }
            const int i = 16 * it + fr; const float gi = gs[i], bi = bs[i]; float v[4];
#pragma unroll
            for (int e = 0; e < 4; ++e) { const int j = 16 * jt + 4 * fq + e; const bool ok = isL ? (j < i) : (j <= i); const float dec = __expf(fminf(gi - gs[j], 0.f)); v[e] = ok ? d[e] * dec * (isL ? bi : 1.f) : 0.f; }
            if (isL) *(f32x4*)(LB + (size_t)chunk * 4096 + i * 64 + 16 * jt + 4 * fq) = (f32x4){v[0], v[1], v[2], v[3]};
            else { u32x2 o; o.x = pk2(v[0], v[1]); o.y = pk2(v[2], v[3]); *(u32x2*)(rec + 57344 + i * 128 + (32 * (jt >> 1) + 8 * fq + 4 * (jt & 1)) * 2) = o; }
        }
        __syncthreads();
    }
    __threadfence();
    __syncthreads();
    { float* Ls = (float*)(smem + wave * 17408); int q = wave;
      for (int chunk = blockIdx.x + q * G; chunk < 2048; chunk += 8 * G) {
          const float* Lg = LB + (size_t)chunk * 4096;
#pragma unroll
          for (int it = 0; it < 16; ++it) { const int idx = (it * 64 + lane) * 4; const int row = idx >> 6, col = idx & 63; *(f32x4*)(Ls + row * 68 + col) = *(const f32x4*)(Lg + idx); }
          asm volatile("s_waitcnt vmcnt(0) lgkmcnt(0)" ::: "memory");
          float Tc[64];
#pragma unroll
          for (int i = 0; i < 64; ++i) { float acc = (lane == i) ? 1.f : 0.f;
#pragma unroll
              for (int j4 = 0; j4 < (i + 3) / 4; ++j4) { const f32x4 l4 = *(const f32x4*)(Ls + i * 68 + 4 * j4);
#pragma unroll
                  for (int e = 0; e < 4; ++e) if (4 * j4 + e < i) acc -= l4[e] * Tc[4 * j4 + e]; }
              Tc[i] = acc; }
          const int x = lane & 31; const int slot = 32 * (lane >> 5) + (x < 16 ? 8 * (x >> 2) + (x & 3) : 8 * ((x - 16) >> 2) + 4 + (x & 3));
          unsigned char* trec = (unsigned char*)P.out + (size_t)chunk * 65536 + 49152 + slot * 2;
#pragma unroll
          for (int i = 0; i < 64; ++i) *(unsigned short*)(trec + i * 128) = (unsigned short)bf1(Tc[i]);
          asm volatile("s_waitcnt lgkmcnt(0)" ::: "memory");
      } }
}

__device__ __forceinline__ void gdn_scan(const Params& P, unsigned char* smem, int bh) {
    int tid_ = threadIdx.x; asm volatile("" : "+v"(tid_)); const int tid = tid_, lane = tid & 63, w = tid >> 6, fr = lane & 15, fq = lane >> 4; const int b = bh >> 2, h = bh & 3; unsigned char* ws = P.ws;
    const bf16_t* PROJ = (const bf16_t*)(ws + WS_BIG); bf16_t* MIXIN = (bf16_t*)(ws + WS_MIXIN); const unsigned char* REC = (const unsigned char*)P.out;
    const unsigned char* BVT = (const unsigned char*)(ws + WS_BVT); const float* GLAST = (const float*)(ws + WS_GLAST);
    unsigned char* Lk = smem; unsigned char* Lq = smem + 17408; unsigned char* Lt = smem + 34816; unsigned char* LT = smem + 53248; unsigned char* Li = smem + 62464; float* Os = (float*)(smem + 71680);
    f32x4 Sacc[8];
#pragma unroll
    for (int j = 0; j < 8; ++j) Sacc[j] = (f32x4){0.f, 0.f, 0.f, 0.f};
    u32x4 st[8];
#define GS_LOAD(ch) do { const unsigned char* r_ = REC + (size_t)(ch) * 65536; _Pragma("unroll") for (int i_ = 0; i_ < 8; ++i_) st[i_] = *(const u32x4*)(r_ + (size_t)(tid + 512 * i_) * 16); } while (0)
#define GS_STORE() do { _Pragma("unroll") for (int i_ = 0; i_ < 8; ++i_) { const int id_ = tid + 512 * i_; unsigned char* d_; \
        if (i_ < 2) d_ = Lk + (id_ >> 4) * 272 + (id_ & 15) * 16; else if (i_ < 4) d_ = Lq + ((id_ - 1024) >> 4) * 272 + (id_ & 15) * 16; \
        else if (i_ < 6) d_ = Lt + ((id_ - 2048) >> 3) * 144 + (id_ & 7) * 16; else if (i_ < 7) d_ = LT + ((id_ - 3072) >> 3) * 144 + (id_ & 7) * 16; \
        else d_ = Li + ((id_ - 3584) >> 3) * 144 + (id_ & 7) * 16; *(u32x4*)d_ = st[i_]; } } while (0)
    GS_LOAD(bh * 32); GS_STORE();
    __syncthreads();
    const float nw0 = P.gdn_norm_w[2 * lane], nw1 = P.gdn_norm_w[2 * lane + 1];
    for (int n = 0; n < 32; ++n) {
        const int chunk = bh * 32 + n;
        if (n + 1 < 32) GS_LOAD(chunk + 1);
        const float glast = GLAST[chunk];
        u32x2 bvw[4];
#pragma unroll
        for (int rt = 0; rt < 4; ++rt) bvw[rt] = *(const u32x2*)(BVT + (size_t)chunk * 16384 + (16 * w + fr) * 128 + (16 * rt + 4 * fq) * 2);
        bf16x8 sb[4];
#pragma unroll
        for (int m = 0; m < 4; ++m) { u32x4 o; o.x = pk2(Sacc[2 * m][0], Sacc[2 * m][1]); o.y = pk2(Sacc[2 * m][2], Sacc[2 * m][3]); o.z = pk2(Sacc[2 * m + 1][0], Sacc[2 * m + 1][1]); o.w = pk2(Sacc[2 * m + 1][2], Sacc[2 * m + 1][3]);
            sb[m] = __builtin_bit_cast(bf16x8, o); }
        f32x4 xacc[4], oacc[4];
#pragma unroll
        for (int rt = 0; rt < 4; ++rt) { xacc[rt] = (f32x4){0.f, 0.f, 0.f, 0.f}; oacc[rt] = (f32x4){0.f, 0.f, 0.f, 0.f};
#pragma unroll
            for (int m = 0; m < 4; ++m) { const bf16x8 a = *(const bf16x8*)(Lk + (16 * rt + fr) * 272 + (32 * m + 8 * fq) * 2), a2 = *(const bf16x8*)(Lq + (16 * rt + fr) * 272 + (32 * m + 8 * fq) * 2);
                xacc[rt] = __builtin_amdgcn_mfma_f32_16x16x32_bf16(a, sb[m], xacc[rt], 0, 0, 0); oacc[rt] = __builtin_amdgcn_mfma_f32_16x16x32_bf16(a2, sb[m], oacc[rt], 0, 0, 0); } }
        bf16x8 xb[2];
#pragma unroll
        for (int mp = 0; mp < 2; ++mp) { float xv[8];
#pragma unroll
            for (int q = 0; q < 2; ++q) { const int rt = 2 * mp + q; xv[4 * q] = bflo(bvw[rt].x) - xacc[rt][0]; xv[4 * q + 1] = bfhi(bvw[rt].x) - xacc[rt][1]; xv[4 * q + 2] = bflo(bvw[rt].y) - xacc[rt][2]; xv[4 * q + 3] = bfhi(bvw[rt].y) - xacc[rt][3]; }
            u32x4 o; o.x = pk2(xv[0], xv[1]); o.y = pk2(xv[2], xv[3]); o.z = pk2(xv[4], xv[5]); o.w = pk2(xv[6], xv[7]); xb[mp] = __builtin_bit_cast(bf16x8, o); }
        f32x4 vacc[4];
#pragma unroll
        for (int rt = 0; rt < 4; ++rt) { vacc[rt] = (f32x4){0.f, 0.f, 0.f, 0.f};
#pragma unroll
            for (int mp = 0; mp < 2; ++mp) { const bf16x8 a = *(const bf16x8*)(LT + (16 * rt + fr) * 144 + (32 * mp + 8 * fq) * 2); vacc[rt] = __builtin_amdgcn_mfma_f32_16x16x32_bf16(a, xb[mp], vacc[rt], 0, 0, 0); } }
        bf16x8 vb[2];
#pragma unroll
        for (int mp = 0; mp < 2; ++mp) { u32x4 o; o.x = pk2(vacc[2 * mp][0], vacc[2 * mp][1]); o.y = pk2(vacc[2 * mp][2], vacc[2 * mp][3]); o.z = pk2(vacc[2 * mp + 1][0], vacc[2 * mp + 1][1]); o.w = pk2(vacc[2 * mp + 1][2], vacc[2 * mp + 1][3]);
            vb[mp] = __builtin_bit_cast(bf16x8, o); }
#pragma unroll
        for (int rt = 0; rt < 4; ++rt)
#pragma unroll
            for (int mp = 0; mp < 2; ++mp) { const bf16x8 a = *(const bf16x8*)(Li + (16 * rt + fr) * 144 + (32 * mp + 8 * fq) * 2); oacc[rt] = __builtin_amdgcn_mfma_f32_16x16x32_bf16(a, vb[mp], oacc[rt], 0, 0, 0); }
#pragma unroll
        for (int j = 0; j < 8; ++j) { Sacc[j] = Sacc[j] * glast;
#pragma unroll
            for (int mp = 0; mp < 2; ++mp) { const bf16x8 a = *(const bf16x8*)(Lt + (16 * j + fr) * 144 + (32 * mp + 8 * fq) * 2); Sacc[j] = __builtin_amdgcn_mfma_f32_16x16x32_bf16(a, vb[mp], Sacc[j], 0, 0, 0); } }
#pragma unroll
        for (int rt = 0; rt < 4; ++rt)
#pragma unroll
            for (int i = 0; i < 4; ++i) Os[(16 * rt + 4 * fq + i) * 128 + 16 * w + fr] = oacc[rt][i];
        __syncthreads();
        if (n + 1 < 32) GS_STORE();
        for (int q = 0; q < 8; ++q) { const int row = w * 8 + q; const size_t m = (size_t)(b * SEQ + n * 64 + row);
            const float o0 = Os[row * 128 + 2 * lane], o1 = Os[row * 128 + 2 * lane + 1];
            const float rstd = rsqrtf(wave_sum(o0 * o0 + o1 * o1) * (1.f / 128.f) + RMS_EPS);
            const unsigned zw = *(const unsigned*)(PROJ + m * NPROJ + C_GZ + h * 128 + 2 * lane);
            *(unsigned*)(MIXIN + m * DM + h * 128 + 2 * lane) = pk2(o0 * rstd * nw0 * silu_f(bflo(zw)), o1 * rstd * nw1 * silu_f(bfhi(zw))); }
        __syncthreads();
    }
#undef GS_LOAD
#undef GS_STORE
}

__device__ __forceinline__ void rowpass1(const Params& P) {
    const int tid = threadIdx.x, lane = tid & 63, wave = tid >> 6; const int gw = blockIdx.x * 8 + wave, NGW = gridDim.x * 8; unsigned char* ws = P.ws;
    const bf16_t* MIX = (const bf16_t*)(ws + WS_BIG); bf16_t* U = (bf16_t*)(ws + WS_U);
    f32x4 w1[4], w2[4];
#pragma unroll
    for (int jj = 0; jj < 4; ++jj) { w1[jj] = *((const f32x4*)P.n_post_attn + lane + 64 * jj); w2[jj] = *((const f32x4*)P.n_pre_mlp + lane + 64 * jj); }
    for (int m = gw; m < MTOK; m += NGW) {
        f32x4 mv[4], xv[4]; float s = 0.f;
#pragma unroll
        for (int jj = 0; jj < 4; ++jj) { const u32x2 w = *(const u32x2*)(MIX + (size_t)m * DM + 4 * lane + 256 * jj); mv[jj] = (f32x4){bflo(w.x), bfhi(w.x), bflo(w.y), bfhi(w.y)};
            xv[jj] = *((const f32x4*)(P.x + (size_t)m * DM) + lane + 64 * jj); s += (mv[jj][0] * mv[jj][0] + mv[jj][1] * mv[jj][1]) + (mv[jj][2] * mv[jj][2] + mv[jj][3] * mv[jj][3]); }
        const float r1 = rsqrtf(wave_sum(s) * (1.f / DM) + RMS_EPS); float s2 = 0.f;
#pragma unroll
        for (int jj = 0; jj < 4; ++jj) { xv[jj] = xv[jj] + mv[jj] * r1 * w1[jj]; *((f32x4*)(P.out + (size_t)m * DM) + lane + 64 * jj) = xv[jj];
            s2 += (xv[jj][0] * xv[jj][0] + xv[jj][1] * xv[jj][1]) + (xv[jj][2] * xv[jj][2] + xv[jj][3] * xv[jj][3]); }
        const float r2 = rsqrtf(wave_sum(s2) * (1.f / DM) + RMS_EPS);
#pragma unroll
        for (int jj = 0; jj < 4; ++jj) { const f32x4 a = xv[jj] * r2 * w2[jj]; u32x2 o; o.x = pk2(a[0], a[1]); o.y = pk2(a[2], a[3]); *(u32x2*)(U + (size_t)m * DM + 4 * lane + 256 * jj) = o; }
    }
}
__device__ __forceinline__ void rowpass2(const Params& P) {
    const int tid = threadIdx.x, lane = tid & 63, wave = tid >> 6; const int gw = blockIdx.x * 8 + wave, NGW = gridDim.x * 8; unsigned char* ws = P.ws;
    const bf16_t* F = (const bf16_t*)(ws + WS_U); bf16_t* H2B = (bf16_t*)(ws + WS_MIXIN);
    f32x4 w1[4];
#pragma unroll
    for (int jj = 0; jj < 4; ++jj) w1[jj] = *((const f32x4*)P.n_post_mlp + lane + 64 * jj);
    for (int m = gw; m < MTOK; m += NGW) {
        f32x4 fv[4], hv[4]; float s = 0.f;
#pragma unroll
        for (int jj = 0; jj < 4; ++jj) { const u32x2 w = *(const u32x2*)(F + (size_t)m * DM + 4 * lane + 256 * jj); fv[jj] = (f32x4){bflo(w.x), bfhi(w.x), bflo(w.y), bfhi(w.y)};
            hv[jj] = *((const f32x4*)(P.out + (size_t)m * DM) + lane + 64 * jj); s += (fv[jj][0] * fv[jj][0] + fv[jj][1] * fv[jj][1]) + (fv[jj][2] * fv[jj][2] + fv[jj][3] * fv[jj][3]); }
        const float r1 = rsqrtf(wave_sum(s) * (1.f / DM) + RMS_EPS);
#pragma unroll
        for (int jj = 0; jj < 4; ++jj) { hv[jj] = hv[jj] + fv[jj] * r1 * w1[jj]; *((f32x4*)(P.out + (size_t)m * DM) + lane + 64 * jj) = hv[jj];
            u32x2 o; o.x = pk2(hv[jj][0], hv[jj][1]); o.y = pk2(hv[jj][2], hv[jj][3]); *(u32x2*)(H2B + (size_t)m * DM + 4 * lane + 256 * jj) = o; }
    }
}

template <int MODE> __device__ __forceinline__ void run_gemm(unsigned char* smem, const bf16_t* A, const bf16_t* Bt, int N, int K, bf16_t* O, int ldc, float* out, const bf16_t* ple) {
    pg8::Gemm g{A, Bt, MTOK, N, K}; pg8::StaticOrder S; S.init(MTOK, N, (int)gridDim.x, (int)blockIdx.x);
    pg8::EpiGen<MODE> E{O, ldc, out, ple};
#ifndef NO_GEMM
    pg8::gemm_phase<pg8::EpiGen<MODE>, pg8::StaticOrder, true, true>((PG8_LAS unsigned char*)smem, g, S, E);
#endif
    __syncthreads();
}

#define GRID_SYNC() do { asm volatile("s_waitcnt vmcnt(0)" ::: "memory"); grid.sync(); __builtin_amdgcn_fence(__ATOMIC_ACQUIRE, "agent"); } while (0)
__global__ void __launch_bounds__(512) fwd_megakernel(Params P) {
    extern __shared__ __attribute__((aligned(16))) unsigned char smem[];
    cg::grid_group grid = cg::this_grid();
    unsigned char* ws = P.ws;
    phase0(P, smem);
    GRID_SYNC();
    run_gemm<0>(smem, (const bf16_t*)(ws + WS_U), (const bf16_t*)(ws + WS_WIN), NPROJ, DM, (bf16_t*)(ws + WS_BIG), NPROJ, nullptr, nullptr);
    GRID_SYNC();
    moba_prep(P, smem);
    gdn_prep(P, smem);
    GRID_SYNC();
    { const int G = gridDim.x; const int ngdn = 64;
      if ((int)blockIdx.x < ngdn) {
#ifndef NO_GDN
 for (int bh = blockIdx.x; bh < 64; bh += ngdn) gdn_scan(P, smem, bh);
#endif
 }
      else { for (int u = blockIdx.x - ngdn; u < 256; u += G - ngdn) { const int bh = u >> 2, pr = u & 3;
#ifndef NO_MOBA
 for (int rep = 0; rep < 2; ++rep) moba_unit(P, smem, bh, rep == 0 ? 7 - pr : pr);
#endif
 } } }
    GRID_SYNC();
    run_gemm<0>(smem, (const bf16_t*)(ws + WS_MIXIN), (const bf16_t*)(ws + WS_WOUT), DM, DM, (bf16_t*)(ws + WS_BIG), DM, nullptr, nullptr);
    GRID_SYNC();
    rowpass1(P);
    GRID_SYNC();
    run_gemm<1>(smem, (const bf16_t*)(ws + WS_U), (const bf16_t*)(ws + WS_WUP), DFF, DM, (bf16_t*)(ws + WS_BIG), DFF, nullptr, nullptr);
    GRID_SYNC();
    run_gemm<0>(smem, (const bf16_t*)(ws + WS_BIG), (const bf16_t*)(ws + WS_WDOWN), DM, DFF, (bf16_t*)(ws + WS_U), DM, nullptr, nullptr);
    GRID_SYNC();
    rowpass2(P);
    run_gemm<0>(smem, (const bf16_t*)(ws + WS_PB), (const bf16_t*)(ws + WS_WPLE), DM, PLED, (bf16_t*)(ws + WS_BIG), DM, nullptr, nullptr);
    GRID_SYNC();
    run_gemm<2>(smem, (const bf16_t*)(ws + WS_MIXIN), (const bf16_t*)(ws + WS_WGATE), DM, DM, nullptr, DM, P.out, (const bf16_t*)(ws + WS_BIG));
}

extern "C" void kernel_launch(void* const* d_in, const int* in_sizes, int n_in, void* d_out, int out_size, void* d_ws, size_t ws_size, hipStream_t stream) {
    static int grid_blocks = 0;
    if (grid_blocks == 0) {
        if (ws_size < WS_END2) { fprintf(stderr, "kernel_launch: workspace too small: %zu < %zu\n", ws_size, (size_t)WS_END2); grid_blocks = -1; return; }
        int dev = 0, cus = 0, per_cu = 0;
        hipGetDevice(&dev); hipDeviceGetAttribute(&cus, hipDeviceAttributeMultiprocessorCount, dev);
        hipFuncSetAttribute((const void*)fwd_megakernel, hipFuncAttributeMaxDynamicSharedMemorySize, LDS_BYTES);
        hipOccupancyMaxActiveBlocksPerMultiprocessor(&per_cu, (const void*)fwd_megakernel, 512, LDS_BYTES);
        if (per_cu < 1) { fprintf(stderr, "kernel_launch: occupancy query says %d blocks per CU\n", per_cu); per_cu = 1; }
        grid_blocks = cus;
        if (grid_blocks > 256) grid_blocks = 256;
    }
    if (grid_blocks < 0) return;
    Params P{};
    P.x = (const float*)d_in[0]; P.p = (const float*)d_in[1]; P.w_in = (const float*)d_in[2]; P.conv_w = (const float*)d_in[3]; P.a_log = (const float*)d_in[4]; P.dt_bias = (const float*)d_in[5];
    P.gdn_norm_w = (const float*)d_in[6]; P.w_out = (const float*)d_in[7]; P.n_pre_attn = (const float*)d_in[8]; P.n_post_attn = (const float*)d_in[9]; P.n_pre_mlp = (const float*)d_in[10];
    P.n_post_mlp = (const float*)d_in[11]; P.w_up = (const float*)d_in[12]; P.w_down = (const float*)d_in[13]; P.w_ple = (const float*)d_in[14]; P.w_gate = (const float*)d_in[15];
    P.out = (float*)d_out; P.ws = (unsigned char*)d_ws;
    for (int d = 0; d < 16; ++d) P.inv_freq[d] = (float)std::pow(500000.0, -(double)d / 16.0);
#ifdef DIAG_POISON
    hipMemsetAsync(d_out, 0xFF, (size_t)MTOK * DM * 4, stream);
    hipMemsetAsync((unsigned char*)d_ws + WS_U, 0xFF, (size_t)MTOK * DM * 2, stream);
    hipMemsetAsync((unsigned char*)d_ws + WS_GLAST, 0xFF, 8192, stream);
#endif
    void* args[] = {&P};
    hipError_t e = hipLaunchCooperativeKernel((const void*)fwd_megakernel, dim3(grid_blocks), dim3(512), args, LDS_BYTES, stream);
    if (e != hipSuccess) fprintf(stderr, "cooperative launch failed: %s (grid %d)\n", hipGetErrorString(e), grid_blocks);
}
```

```cpp
#include <hip/hip_runtime.h>
#include <hip/hip_cooperative_groups.h>
#include <cstdio>
#include <cstdint>
#include <cmath>
namespace cg = cooperative_groups;
namespace pg8 {
#define PG8_LAS __attribute__((address_space(3)))
typedef unsigned short bf16_t;
typedef short bf16x8 __attribute__((ext_vector_type(8)));
typedef float f32x4 __attribute__((ext_vector_type(4)));
typedef unsigned u32x4 __attribute__((ext_vector_type(4)));
constexpr int BM = 256, BK = 64, HALF = 128, HTB = HALF * BK * 2  , STAGE_BYTES = 8 * HTB, NXCD = 8, WGM = 8;

__host__ __device__ __forceinline__ int lds_byte(int r, int c) { const int st = (r >> 4) * 2 + (c >> 5), rr = r & 15, cc = c & 31, ob = rr * 64 + cc * 2; return st * 1024 + (ob ^ (((ob >> 9) & 1) << 5)); }
__host__ __device__ __forceinline__ void stage_rc(int b, int& R, int& C) { const int st = b / 1024, sb = b % 1024, swz = sb ^ (((sb >> 9) & 1) << 5); R = (st >> 1) * 16 + swz / 64; C = (st & 1) * 32 + (swz % 64) / 2; }
__host__ __device__ __forceinline__ int perm32(int rho) { const int n = rho >> 4, i = rho & 15; return 8 * (i >> 2) + 4 * n + (i & 3); }

struct Unit { int pm, pn; };
struct Gemm { const bf16_t* A; const bf16_t* Bt; int M, N, K; };

struct StaticOrder {
    int nM, nN, nwg, G, c;
    __host__ __device__ void init(int M, int N, int G_, int c_) { nM = M / BM; nN = N / BM; nwg = nM * nN; G = G_; c = c_; }
    __host__ __device__ bool next(int i, Unit& u) const {
        const long L = (long)i * G + c; if (L >= nwg) return false;
        int wgid = (int)L; { const int q = nwg / NXCD, r = nwg % NXCD, xcd = wgid % NXCD, off = wgid / NXCD; wgid = (xcd < r ? xcd * (q + 1) : r * (q + 1) + (xcd - r) * q) + off; }
        const int nig = WGM * nN, gid = wgid / nig, fm = gid * WGM, gsz = (nM - fm) < WGM ? (nM - fm) : WGM;
        u.pm = fm + ((wgid % nig) % gsz); u.pn = (wgid % nig) / gsz; return true;
    }
    __device__ __forceinline__ void a_ready(const Unit&) const {}
    __device__ __forceinline__ void done(const Unit&) const {}
};

typedef __bf16 bf16x2_cv __attribute__((ext_vector_type(2)));
typedef float f32x2_cv __attribute__((ext_vector_type(2)));
__device__ __forceinline__ unsigned cvt_pk_bf16(float lo, float hi) { f32x2_cv v = {lo, hi}; bf16x2_cv b = __builtin_convertvector(v, bf16x2_cv); return __builtin_bit_cast(unsigned, b); }
template <int MODE> struct EpiGen {
    static constexpr bool PERM = true, AFTER_DRAIN = false;
    bf16_t* O; int ldc; float* out; const bf16_t* ple; const float* rs;
    __device__ __forceinline__ void operator()(const f32x4 (&acc)[2][2][4][2], const Unit& u, int wr, int wc, int fr, int fq) const {
        const int row0 = u.pm * BM + wr * 64 + fr; const int col0 = u.pn * BM + wc * 32 + 8 * fq;
        if (MODE == 2) {
#pragma unroll
            for (int ai = 0; ai < 2; ++ai) {
                f32x4 h0[4][2], h1[4][2]; u32x4 pw[4][2];
#pragma unroll
                for (int m = 0; m < 4; ++m)
#pragma unroll
                    for (int bj = 0; bj < 2; ++bj) { const size_t row = (size_t)(row0 + ai * HALF + m * 16); const int col = col0 + bj * HALF;
                        const u32x4 hw = *(const u32x4*)(O + row * 1024 + col);
                        h0[m][bj] = (f32x4){__uint_as_float(hw.x << 16), __uint_as_float(hw.x & 0xffff0000u), __uint_as_float(hw.y << 16), __uint_as_float(hw.y & 0xffff0000u)};
                        h1[m][bj] = (f32x4){__uint_as_float(hw.z << 16), __uint_as_float(hw.z & 0xffff0000u), __uint_as_float(hw.w << 16), __uint_as_float(hw.w & 0xffff0000u)};
                        pw[m][bj] = *(const u32x4*)(ple + row * 1024 + col); }
#pragma unroll
                for (int m = 0; m < 4; ++m)
#pragma unroll
                    for (int bj = 0; bj < 2; ++bj) { const size_t row = (size_t)(row0 + ai * HALF + m * 16); const int col = col0 + bj * HALF; float* op = out + row * 1024 + col;
                        const f32x4 v0 = acc[ai][bj][m][0], v1 = acc[ai][bj][m][1]; const u32x4 w = pw[m][bj];
                        const f32x4 p0 = {__uint_as_float(w.x << 16), __uint_as_float(w.x & 0xffff0000u), __uint_as_float(w.y << 16), __uint_as_float(w.y & 0xffff0000u)};
                        const f32x4 p1 = {__uint_as_float(w.z << 16), __uint_as_float(w.z & 0xffff0000u), __uint_as_float(w.w << 16), __uint_as_float(w.w & 0xffff0000u)};
                        f32x4 o0, o1;
#pragma unroll
                        for (int e = 0; e < 4; ++e) { o0[e] = h0[m][bj][e] + p0[e] * __builtin_amdgcn_rcpf(1.f + __expf(-v0[e])); o1[e] = h1[m][bj][e] + p1[e] * __builtin_amdgcn_rcpf(1.f + __expf(-v1[e])); }
                        *(f32x4*)op = o0; *(f32x4*)(op + 4) = o1; }
            }
            return;
        }
        float rsv[2][4];
#pragma unroll
        for (int ai = 0; ai < 2; ++ai)
#pragma unroll
            for (int m = 0; m < 4; ++m) rsv[ai][m] = (MODE == 4 || MODE == 5) ? rs[row0 + ai * HALF + m * 16] : 1.f;
#pragma unroll
        for (int ai = 0; ai < 2; ++ai)
#pragma unroll
            for (int m = 0; m < 4; ++m) {
                const size_t row = (size_t)(row0 + ai * HALF + m * 16);
                float rsc = 1.f; if (MODE == 4) rsc = rsv[ai][m]; if (MODE == 5) rsc = rsv[ai][m] * rsv[ai][m];
#pragma unroll
                for (int bj = 0; bj < 2; ++bj) {
                    f32x4 v0 = acc[ai][bj][m][0], v1 = acc[ai][bj][m][1];
                    const int col = col0 + bj * HALF;
                    if (MODE == 1 || MODE == 5) {
#pragma unroll
                        for (int e = 0; e < 4; ++e) { float a = fmaxf(v0[e], 0.f), b = fmaxf(v1[e], 0.f); v0[e] = a * a; v1[e] = b * b; }
                    }
                    if (MODE == 4 || MODE == 5) { v0 = v0 * rsc; v1 = v1 * rsc; }
                    u32x4 w; w.x = cvt_pk_bf16(v0[0], v0[1]); w.y = cvt_pk_bf16(v0[2], v0[3]); w.z = cvt_pk_bf16(v1[0], v1[1]); w.w = cvt_pk_bf16(v1[2], v1[3]);
                    *(u32x4*)(O + row * ldc + col) = w;
                }
            }
    }
};
template <class Epi, class Sched, bool ALIGN_EPI = false, bool SP2 = false>
__device__ __forceinline__ void gemm_phase(PG8_LAS unsigned char* lds, const Gemm g, const Sched& S, const Epi& E) {
    int tid_ = threadIdx.x; asm volatile("" : "+v"(tid_)); const int tid = tid_, wid = __builtin_amdgcn_readfirstlane(tid >> 6), lane = tid & 63, wr = wid >> 2, wc = wid & 3, fr = lane & 15, fq = lane >> 4;
    const int K = g.K, nt = K / BK;
    unsigned voffA[2], voffB[2];
#pragma unroll
    for (int i = 0; i < 2; ++i) { int R, C; stage_rc(tid * 16 + i * 8192, R, C); const int Rb = Epi::PERM ? ((R & ~31) + perm32(R & 31)) : R;
        voffA[i] = (unsigned)(R * K + C) * 2u; voffB[i] = (unsigned)(Rb * K + C) * 2u; }
    const size_t kstep = (size_t)(BK * 2);
    const size_t hstep = (size_t)HALF * K * 2;
    const size_t tstep = 2 * hstep;
    const unsigned ldsw = (unsigned)wid * 1024u;
    const int aoff = lds_byte(wr * 64 + fr, fq * 8), boff = lds_byte(wc * 32 + fr, fq * 8);
#define PG8_SA(b, h) (((b) * 2 + (h)) * HTB)
#define PG8_SB(b, h) ((4 + (b) * 2 + (h)) * HTB)
#define PG8_STAGE(bufoff, gbase, voff) do { _Pragma("unroll") for (int _i = 0; _i < 2; ++_i) \
        __builtin_amdgcn_global_load_lds((const unsigned*)((const char*)(gbase) + (voff)[_i]), (PG8_LAS unsigned*)(lds + (bufoff) + ldsw + _i * 8192), 16, 0, 0); } while (0)
#define PG8_LDA(dst, b, h) do { _Pragma("unroll") for (int m = 0; m < 4; ++m) _Pragma("unroll") for (int k = 0; k < 2; ++k) dst[m][k] = *(const PG8_LAS bf16x8*)(lds + PG8_SA(b, h) + aoff + m * 2048 + k * 1024); } while (0)
#define PG8_LDB(dst, b, h) do { _Pragma("unroll") for (int n = 0; n < 2; ++n) _Pragma("unroll") for (int k = 0; k < 2; ++k) dst[n][k] = *(const PG8_LAS bf16x8*)(lds + PG8_SB(b, h) + boff + n * 2048 + k * 1024); } while (0)
#define PG8_MMA(ai, bj, At, Bt) do { __builtin_amdgcn_s_setprio(1); _Pragma("unroll") for (int m = 0; m < 4; ++m) _Pragma("unroll") for (int n = 0; n < 2; ++n) _Pragma("unroll") for (int k = 0; k < 2; ++k) \
        acc[ai][bj][m][n] = __builtin_amdgcn_mfma_f32_16x16x32_bf16(Bt[n][k], At[m][k], acc[ai][bj][m][n], 0, 0, 0); __builtin_amdgcn_s_setprio(0); } while (0)
#define PG8_WAIT_V(n) asm volatile("s_waitcnt vmcnt(" #n ")" ::: "memory")
#define PG8_WAIT_L(n) asm volatile("s_waitcnt lgkmcnt(" #n ")" ::: "memory")
#define PG8_BAR __builtin_amdgcn_s_barrier()
#define PG8_SCHED __builtin_amdgcn_sched_barrier(0)
    Unit cur, nxt; int ui = 0;
    if (!S.next(0, cur)) return;
    f32x4 acc[2][2][4][2];
#pragma unroll
    for (int a = 0; a < 2; ++a)
#pragma unroll
        for (int b = 0; b < 2; ++b)
#pragma unroll
            for (int m = 0; m < 4; ++m)
#pragma unroll
                for (int n = 0; n < 2; ++n) acc[a][b][m][n] = (f32x4){0.f, 0.f, 0.f, 0.f};
    bf16x8 At[4][2], B0[2][2], B1[2][2];
    const char* cA = (const char*)g.A + (size_t)cur.pm * tstep; const char* cB = (const char*)g.Bt + (size_t)cur.pn * tstep;
    S.a_ready(cur);
    if constexpr (SP2) {
        PG8_STAGE(PG8_SB(0, 0), cB, voffB); PG8_STAGE(PG8_SB(0, 1), cB + hstep, voffB); PG8_STAGE(PG8_SA(0, 0), cA, voffA); PG8_STAGE(PG8_SA(0, 1), cA + hstep, voffA);
        if (wr == 1) PG8_BAR;
        PG8_WAIT_V(2); PG8_BAR;
        PG8_STAGE(PG8_SB(1, 0), cB + kstep, voffB); PG8_STAGE(PG8_SA(1, 0), cA + kstep, voffA); PG8_STAGE(PG8_SB(1, 1), cB + hstep + kstep, voffB);
        PG8_WAIT_V(6); PG8_BAR;
    } else {
        PG8_STAGE(PG8_SB(0, 0), cB, voffB); PG8_STAGE(PG8_SA(0, 0), cA, voffA); PG8_STAGE(PG8_SB(0, 1), cB + hstep, voffB); PG8_STAGE(PG8_SA(0, 1), cA + hstep, voffA);
        if (wr == 1) PG8_BAR;
        PG8_WAIT_V(4); PG8_BAR;
        PG8_STAGE(PG8_SB(1, 0), cB + kstep, voffB); PG8_STAGE(PG8_SA(1, 0), cA + kstep, voffA); PG8_STAGE(PG8_SB(1, 1), cB + hstep + kstep, voffB);
        PG8_WAIT_V(6); PG8_BAR;
    }
    for (;;) {
        const bool has_next = S.next(ui + 1, nxt);
        const char* nA = has_next ? (const char*)g.A + (size_t)nxt.pm * tstep : cA; const char* nB = has_next ? (const char*)g.Bt + (size_t)nxt.pn * tstep : cB;
        for (int t = 0; t < nt; t += 2) {
            const bool last = (t == nt - 2);
            const char* a1 = cA + (size_t)(t + 1) * kstep;
            const char* a2 = last ? nA : cA + (size_t)(t + 2) * kstep; const char* b2 = last ? nB : cB + (size_t)(t + 2) * kstep;
            const char* a3 = a2 + kstep; const char* b3 = b2 + kstep;
            if (last && has_next) S.a_ready(nxt);
            if constexpr (SP2) {
            PG8_LDB(B0, 0, 0); PG8_LDB(B1, 0, 1); PG8_SCHED; PG8_LDA(At, 0, 0); PG8_STAGE(PG8_SA(1, 1), a1 + hstep, voffA);
            PG8_WAIT_V(8); PG8_WAIT_L(0); PG8_BAR; PG8_MMA(0, 0, At, B0); PG8_MMA(0, 1, At, B1); PG8_BAR; PG8_SCHED;
            PG8_LDA(At, 0, 1); PG8_STAGE(PG8_SB(0, 0), b2, voffB); PG8_STAGE(PG8_SB(0, 1), b2 + hstep, voffB); PG8_STAGE(PG8_SA(0, 0), a2, voffA);
            PG8_WAIT_V(8); PG8_WAIT_L(0); PG8_BAR; PG8_MMA(1, 0, At, B0); PG8_MMA(1, 1, At, B1); PG8_BAR; PG8_SCHED;
            PG8_LDB(B0, 1, 0); PG8_LDB(B1, 1, 1); PG8_SCHED; PG8_LDA(At, 1, 0); PG8_STAGE(PG8_SA(0, 1), a2 + hstep, voffA);
            PG8_WAIT_V(8); PG8_WAIT_L(0); PG8_BAR; PG8_MMA(0, 0, At, B0); PG8_MMA(0, 1, At, B1); PG8_BAR; PG8_SCHED;
            PG8_LDA(At, 1, 1); PG8_STAGE(PG8_SB(1, 0), b3, voffB); PG8_STAGE(PG8_SB(1, 1), b3 + hstep, voffB); PG8_STAGE(PG8_SA(1, 0), a3, voffA);
            PG8_WAIT_V(8); PG8_WAIT_L(0); PG8_BAR; PG8_MMA(1, 0, At, B0); PG8_MMA(1, 1, At, B1); PG8_BAR; PG8_SCHED;
            } else {
            PG8_LDB(B0, 0, 0); PG8_SCHED; PG8_LDA(At, 0, 0); PG8_STAGE(PG8_SA(1, 1), a1 + hstep, voffA);
            PG8_WAIT_L(8); PG8_BAR; PG8_WAIT_L(0); PG8_MMA(0, 0, At, B0); PG8_BAR; PG8_SCHED;
            PG8_LDB(B1, 0, 1); PG8_STAGE(PG8_SB(0, 0), b2, voffB);
            PG8_BAR; PG8_WAIT_L(0); PG8_MMA(0, 1, At, B1); PG8_BAR;
            PG8_LDA(At, 0, 1); PG8_STAGE(PG8_SA(0, 0), a2, voffA);
            PG8_BAR; PG8_WAIT_L(0); PG8_MMA(1, 0, At, B0); PG8_BAR; PG8_SCHED;
            PG8_STAGE(PG8_SB(0, 1), b2 + hstep, voffB);
            PG8_WAIT_V(6); PG8_BAR; PG8_MMA(1, 1, At, B1); PG8_BAR;
            PG8_LDB(B0, 1, 0); PG8_SCHED; PG8_LDA(At, 1, 0); PG8_STAGE(PG8_SA(0, 1), a2 + hstep, voffA);
            PG8_WAIT_L(8); PG8_BAR; PG8_WAIT_L(0); PG8_MMA(0, 0, At, B0); PG8_BAR; PG8_SCHED;
            PG8_LDB(B1, 1, 1); PG8_STAGE(PG8_SB(1, 0), b3, voffB);
            PG8_BAR; PG8_WAIT_L(0); PG8_MMA(0, 1, At, B1); PG8_BAR;
            PG8_LDA(At, 1, 1); PG8_STAGE(PG8_SA(1, 0), a3, voffA);
            PG8_BAR; PG8_WAIT_L(0); PG8_MMA(1, 0, At, B0); PG8_BAR; PG8_SCHED;
            PG8_STAGE(PG8_SB(1, 1), b3 + hstep, voffB);
            PG8_WAIT_V(6); PG8_BAR; PG8_MMA(1, 1, At, B1); PG8_BAR;
            }
        }
        if constexpr (ALIGN_EPI) { if (wr == 0) PG8_BAR; }
        if constexpr (!Epi::AFTER_DRAIN) { E(acc, cur, wr, wc, fr, fq); S.done(cur); }
        if (!has_next) break;
#pragma unroll
        for (int a = 0; a < 2; ++a)
#pragma unroll
            for (int b = 0; b < 2; ++b)
#pragma unroll
                for (int m = 0; m < 4; ++m)
#pragma unroll
                    for (int n = 0; n < 2; ++n) acc[a][b][m][n] = (f32x4){0.f, 0.f, 0.f, 0.f};
        cur = nxt; cA = nA; cB = nB; ++ui;
        if constexpr (ALIGN_EPI) { if (wr == 1) PG8_BAR; }
    }
    PG8_WAIT_V(0);
    if constexpr (!ALIGN_EPI) { if (wr == 0) PG8_BAR; }
    PG8_BAR;
    if constexpr (Epi::AFTER_DRAIN) { E.fused(acc, cur, wr, wc, fr, fq, lds, wid, lane); S.done(cur); }
#undef PG8_SA
#undef PG8_SB
#undef PG8_STAGE
#undef PG8_LDA
#undef PG8_LDB
#undef PG8_MMA
#undef PG8_WAIT_V
#undef PG8_WAIT_L
#undef PG8_BAR
#undef PG8_SCHED
}
}
typedef pg8::bf16_t bf16_t;
typedef pg8::bf16x8 bf16x8;
typedef pg8::f32x4 f32x4;
typedef pg8::u32x4 u32x4;
typedef unsigned u32x2 __attribute__((ext_vector_type(2)));
#define LAS __attribute__((address_space(3)))
constexpr int MTOK = 32768, DM = 1024, SEQ = 2048, NPROJ = 3584, DFF = 4096, PLED = 256, LDWIN = 3592;
constexpr int C_GQ = 0, C_GK = 512, C_GV = 1024, C_GZ = 1536, C_MQ = 2048, C_MK = 2560, C_MV = 3072;
constexpr float RMS_EPS = 1e-6f;
constexpr int LDS_BYTES = 143360;
constexpr size_t WS_KMAX = 0;
constexpr size_t WS_WIN = 4096, WS_WOUT = WS_WIN + (size_t)NPROJ * DM * 2, WS_WUP = WS_WOUT + (size_t)DM * DM * 2, WS_WDOWN = WS_WUP + (size_t)DFF * DM * 2,
    WS_WGATE = WS_WDOWN + (size_t)DFF * DM * 2, WS_WPLE = WS_WGATE + (size_t)DM * DM * 2, WS_ROPE = WS_WPLE + (size_t)DM * PLED * 2, WS_LG = WS_ROPE + (size_t)SEQ * 32 * 4,
    WS_KMEAN = WS_LG + (size_t)MTOK * 8 * 4, WS_PB = WS_KMEAN + (size_t)64 * 8 * 128 * 4, WS_U = WS_PB + (size_t)MTOK * PLED * 2, WS_VT = WS_U + (size_t)MTOK * DM * 2,
    WS_MIXIN = WS_VT + (size_t)64 * 128 * SEQ * 2, WS_BIG = WS_MIXIN + (size_t)MTOK * DM * 2, WS_END = WS_BIG + (size_t)MTOK * DFF * 2;
constexpr size_t WS_RS0 = WS_END + 8192 + (size_t)2048 * 16384 + 256 + 16384, WS_RS2 = WS_RS0 + (size_t)MTOK * 4, WS_TOTAL = WS_RS2 + (size_t)MTOK * 4;

struct Params {
    const float *x, *p, *w_in, *conv_w, *a_log, *dt_bias, *gdn_norm_w, *w_out, *n_pre_attn, *n_post_attn, *n_pre_mlp, *n_post_mlp, *w_up, *w_down, *w_ple, *w_gate;
    float* out; unsigned char* ws;
    float inv_freq[16];
    int coop_marker, pad;
};

#define DPP_ROR_(v_, n_) __builtin_bit_cast(float, __builtin_amdgcn_update_dpp(0, __builtin_bit_cast(int, (v_)), 0x120 + (n_), 0xf, 0xf, false))
__device__ __forceinline__ float wave_sum(float v) {
    v += DPP_ROR_(v, 8); v += DPP_ROR_(v, 4); v += DPP_ROR_(v, 2); v += DPP_ROR_(v, 1);
    v += __shfl_xor(v, 16); v += __shfl_xor(v, 32);
    return v;
}
#define ROWLOOP3(BUFT, LOADF, PROC) do { BUFT A_, B_, C_; int m = gw; LOADF(A_, m); LOADF(B_, min(m + NGW, MTOK - 1)); \
    for (;; m += 3 * NGW) { \
        LOADF(C_, min(m + 2 * NGW, MTOK - 1)); \
        PROC(A_, m); if (m + NGW >= MTOK) break; \
        LOADF(A_, min(m + 3 * NGW, MTOK - 1)); \
        PROC(B_, m + NGW); if (m + 2 * NGW >= MTOK) break; \
        LOADF(B_, min(m + 4 * NGW, MTOK - 1)); \
        PROC(C_, m + 2 * NGW); if (m + 3 * NGW >= MTOK) break; } } while (0)
__device__ __forceinline__ float bflo(unsigned w) { return __uint_as_float(w << 16); }
__device__ __forceinline__ float bfhi(unsigned w) { return __uint_as_float(w & 0xffff0000u); }
__device__ __forceinline__ unsigned pk2(float lo, float hi) { return pg8::cvt_pk_bf16(lo, hi); }
__device__ __forceinline__ float silu_f(float v) { return v * __builtin_amdgcn_rcpf(1.f + __expf(-v)); }

__device__ __forceinline__ void transpose_item(const float* W, int ldw, int K, int k0, int srccol0, bf16_t* WT, int n0, float* scr, int lane, const float* kscale) {
    f32x4 ldv[8];
#pragma unroll
    for (int i = 0; i < 8; ++i) ldv[i] = *(const f32x4*)(W + (size_t)(k0 + 8 * i + (lane >> 3)) * ldw + srccol0 + 4 * (lane & 7));
#pragma unroll
    for (int i = 0; i < 8; ++i) { float* d = scr + (8 * i + (lane >> 3)) * 33 + 4 * (lane & 7); const float sc = kscale ? kscale[k0 + 8 * i + (lane >> 3)] : 1.f;
        d[0] = ldv[i][0] * sc; d[1] = ldv[i][1] * sc; d[2] = ldv[i][2] * sc; d[3] = ldv[i][3] * sc; }
    __builtin_amdgcn_s_waitcnt(0xc07f); asm volatile("s_waitcnt lgkmcnt(0)" ::: "memory");
    const int c = lane & 7;
#pragma unroll
    for (int j = 0; j < 4; ++j) { const int n = (lane >> 3) + 8 * j; const float* s = scr + (8 * c) * 33 + n;
        u32x4 o; o.x = pk2(s[0 * 33], s[1 * 33]); o.y = pk2(s[2 * 33], s[3 * 33]); o.z = pk2(s[4 * 33], s[5 * 33]); o.w = pk2(s[6 * 33], s[7 * 33]);
        *(u32x4*)(WT + (size_t)(n0 + n) * K + k0 + 8 * c) = o; }
    asm volatile("s_waitcnt lgkmcnt(0)" ::: "memory");
}
__device__ __forceinline__ void transpose_matrix(const float* W, int ldw, int K, int N, bool is_win, bf16_t* WT, float* scr, int gw, int NGW, int lane, const float* kscale = nullptr) {
    const int nblk = N / 32, items = (K / 64) * nblk;
    for (int it = gw; it < items; it += NGW) { const int kb = it / nblk, nb = it % nblk; const int n0 = nb * 32; const int src = is_win ? (n0 >= 2048 ? n0 + 8 : n0) : n0;
        transpose_item(W, ldw, K, kb * 64, src, WT, n0, scr, lane, kscale); }
}
__device__ __forceinline__ void phase0(const Params& P, unsigned char* smem) {
    int tid_ = threadIdx.x; asm volatile("" : "+v"(tid_)); const int tid = tid_, lane = tid & 63, wave = __builtin_amdgcn_readfirstlane(tid >> 6); const int G = gridDim.x; const int gw = blockIdx.x * 8 + wave, NGW = G * 8;
    unsigned char* ws = P.ws;
    float* scr = (float*)(smem + 32768) + wave * (64 * 33);
    transpose_matrix(P.w_in, LDWIN, DM, NPROJ, true, (bf16_t*)(ws + WS_WIN), scr, gw, NGW, lane, P.n_pre_attn);
    transpose_matrix(P.w_out, DM, DM, DM, false, (bf16_t*)(ws + WS_WOUT), scr, gw, NGW, lane);
    transpose_matrix(P.w_up, DFF, DM, DFF, false, (bf16_t*)(ws + WS_WUP), scr, gw, NGW, lane, P.n_pre_mlp);
    transpose_matrix(P.w_down, DM, DFF, DM, false, (bf16_t*)(ws + WS_WDOWN), scr, gw, NGW, lane);
    transpose_matrix(P.w_gate, DM, DM, DM, false, (bf16_t*)(ws + WS_WGATE), scr, gw, NGW, lane);
    transpose_matrix(P.w_ple, DM, PLED, DM, false, (bf16_t*)(ws + WS_WPLE), scr, gw, NGW, lane);
    { float* rope = (float*)(ws + WS_ROPE);
      for (int i = blockIdx.x * 512 + tid; i < SEQ * 16; i += G * 512) { const int t = i >> 4, d = i & 15; const float ang = (float)t * P.inv_freq[d];
          double rev = (double)ang * 0.15915494309189533577; rev -= __builtin_rint(rev); const float fr = (float)rev;
          rope[t * 32 + d] = __builtin_amdgcn_cosf(fr); rope[t * 32 + 16 + d] = __builtin_amdgcn_sinf(fr); } }
    { bf16_t* pb = (bf16_t*)(ws + WS_PB); const size_t n8 = (size_t)MTOK * PLED / 8;
      for (size_t i = (size_t)blockIdx.x * 512 + tid; i < n8; i += (size_t)G * 512) { const f32x4 a = *(const f32x4*)(P.p + i * 8), b = *(const f32x4*)(P.p + i * 8 + 4);
          u32x4 o; o.x = pk2(a[0], a[1]); o.y = pk2(a[2], a[3]); o.z = pk2(b[0], b[1]); o.w = pk2(b[2], b[3]); *(u32x4*)(pb + i * 8) = o; } }
    __syncthreads();
    { bf16_t* U = (bf16_t*)(ws + WS_U); float* LG = (float*)(ws + WS_LG);
      f32x4 wn[4];
#pragma unroll
      for (int j = 0; j < 4; ++j) wn[j] = *((const f32x4*)P.n_pre_attn + lane + 64 * j);
      f32x4 wl0[4][4], wl1[4][4];
#pragma unroll
      for (int j = 0; j < 4; ++j)
#pragma unroll
          for (int e = 0; e < 4; ++e) { const float* wp = P.w_in + (size_t)(4 * lane + 256 * j + e) * LDWIN + 2048; wl0[j][e] = *(const f32x4*)wp; wl1[j][e] = *(const f32x4*)(wp + 4); }
#define PN_LOAD(buf, mm) do { _Pragma("unroll") for (int j_ = 0; j_ < 4; ++j_) buf.c[j_] = *((const f32x4*)(P.x + (size_t)(mm) * DM) + lane + 64 * j_); } while (0)
#define PN_PROC(buf, mm) do { const int m_ = (mm); f32x4 v[4]; float s_ = 0.f; \
          _Pragma("unroll") for (int j = 0; j < 4; ++j) { v[j] = buf.c[j]; s_ += (v[j][0] * v[j][0] + v[j][1] * v[j][1]) + (v[j][2] * v[j][2] + v[j][3] * v[j][3]); } \
          const float rstd = rsqrtf(wave_sum(s_) * (1.f / DM) + RMS_EPS); \
          float lg[8]; _Pragma("unroll") for (int c = 0; c < 8; ++c) lg[c] = 0.f; \
          if (lane == 0) ((float*)(ws + WS_RS0))[m_] = rstd; \
          _Pragma("unroll") for (int j = 0; j < 4; ++j) { \
              u32x2 o; o.x = pk2(v[j][0], v[j][1]); o.y = pk2(v[j][2], v[j][3]); *(u32x2*)(U + (size_t)m_ * DM + 4 * lane + 256 * j) = o; v[j] = v[j] * rstd * wn[j]; \
              _Pragma("unroll") for (int e = 0; e < 4; ++e) { _Pragma("unroll") for (int c = 0; c < 4; ++c) { lg[c] += v[j][e] * wl0[j][e][c]; lg[4 + c] += v[j][e] * wl1[j][e][c]; } } } \
            \
          { const bool b0 = (lane & 1) != 0, b1 = (lane & 2) != 0, b2 = (lane & 4) != 0; float h4[4], h2[2], h1; \
            _Pragma("unroll") for (int i = 0; i < 4; ++i) { const float send = b0 ? lg[i] : lg[i + 4], keep = b0 ? lg[i + 4] : lg[i]; h4[i] = keep + __shfl_xor(send, 1); } \
            _Pragma("unroll") for (int i = 0; i < 2; ++i) { const float send = b1 ? h4[i] : h4[i + 2], keep = b1 ? h4[i + 2] : h4[i]; h2[i] = keep + __shfl_xor(send, 2); } \
            { const float send = b2 ? h2[0] : h2[1], keep = b2 ? h2[1] : h2[0]; h1 = keep + __shfl_xor(send, 4); } \
            h1 += __shfl_xor(h1, 8); h1 += __shfl_xor(h1, 16); h1 += __shfl_xor(h1, 32); \
            if (lane < 8) LG[(size_t)m_ * 8 + 4 * (lane & 1) + 2 * ((lane >> 1) & 1) + ((lane >> 2) & 1)] = h1; } } while (0)
      struct XBuf { f32x4 c[4]; };
      ROWLOOP3(XBuf, PN_LOAD, PN_PROC);
#undef PN_LOAD
#undef PN_PROC
    }
}

__device__ __forceinline__ void moba_prep(const Params& P, unsigned char* smem) {
    int tid_ = threadIdx.x; asm volatile("" : "+v"(tid_)); const int tid = tid_; unsigned char* ws = P.ws;
    bf16_t* PROJ = (bf16_t*)(ws + WS_BIG); const float* rope = (const float*)(ws + WS_ROPE); float* KMEAN = (float*)(ws + WS_KMEAN); bf16_t* VT = (bf16_t*)(ws + WS_VT);
    unsigned char* vt = smem;
    float* red = (float*)(smem + 69632);
    const int p = tid & 15, r = tid >> 4;
    for (int unit = blockIdx.x; unit < 512; unit += gridDim.x) {
        const int bh = unit >> 3, n = unit & 7, b = bh >> 2, h = bh & 3; const int m0 = b * SEQ + n * 256;
        float ksum[8]; float kmax2 = 0.f;
#pragma unroll
        for (int e = 0; e < 8; ++e) ksum[e] = 0.f;
        u32x4 lq[8], lk[8], lv[8];
#pragma unroll
        for (int i = 0; i < 8; ++i) { const size_t m = (size_t)(m0 + r + 32 * i); const bf16_t* bp = PROJ + m * NPROJ + h * 128 + 8 * p;
            lq[i] = *(const u32x4*)(bp + C_MQ); lk[i] = *(const u32x4*)(bp + C_MK); lv[i] = *(const u32x4*)(bp + C_MV); }
#pragma unroll
        for (int i = 0; i < 8; ++i) { const int row = r + 32 * i, t = n * 256 + row; const size_t m = (size_t)(m0 + row);
#pragma unroll
            for (int ten = 0; ten < 2; ++ten) {
                bf16_t* ptr = PROJ + m * NPROJ + (ten == 0 ? C_MQ : C_MK) + h * 128 + 8 * p;
                const u32x4 w = (ten == 0) ? lq[i] : lk[i]; u32x4 o; o.x = __shfl_xor(w.x, 2); o.y = __shfl_xor(w.y, 2); o.z = __shfl_xor(w.z, 2); o.w = __shfl_xor(w.w, 2);
                float a[8] = {bflo(w.x), bfhi(w.x), bflo(w.y), bfhi(w.y), bflo(w.z), bfhi(w.z), bflo(w.w), bfhi(w.w)};
                if (p < 4) {
                    const float bb[8] = {bflo(o.x), bfhi(o.x), bflo(o.y), bfhi(o.y), bflo(o.z), bfhi(o.z), bflo(o.w), bfhi(o.w)};
                    const float* cs = rope + t * 32 + 8 * (p & 1);
                    const f32x4 c0 = *(const f32x4*)cs, c1 = *(const f32x4*)(cs + 4), s0 = *(const f32x4*)(cs + 16), s1 = *(const f32x4*)(cs + 20);
                    const float cc[8] = {c0[0], c0[1], c0[2], c0[3], c1[0], c1[1], c1[2], c1[3]}, ss[8] = {s0[0], s0[1], s0[2], s0[3], s1[0], s1[1], s1[2], s1[3]};
#pragma unroll
                    for (int e = 0; e < 8; ++e) a[e] = (p < 2) ? (a[e] * cc[e] - bb[e] * ss[e]) : (a[e] * cc[e] + bb[e] * ss[e]);
                    u32x4 st; st.x = pk2(a[0], a[1]); st.y = pk2(a[2], a[3]); st.z = pk2(a[4], a[5]); st.w = pk2(a[6], a[7]);
                    *(u32x4*)ptr = st;
                }
                if (ten == 1) { float kn = 0.f;
#pragma unroll
                    for (int e = 0; e < 8; ++e) { ksum[e] += a[e]; const float ab = bflo(pk2(a[e], 0.f)); kn += ab * ab; }
                    kn += __shfl_xor(kn, 1); kn += __shfl_xor(kn, 2); kn += __shfl_xor(kn, 4); kn += __shfl_xor(kn, 8); kmax2 = fmaxf(kmax2, kn);
                }
            }
            *(u32x4*)(vt + row * 272 + 16 * p) = lv[i];
        }
#pragma unroll
        for (int e = 0; e < 8; ++e) red[r * 128 + 8 * p + e] = ksum[e];
        if (p == 0) red[4096 + r] = kmax2;
        __syncthreads();
        if (tid < 128) { float s = 0.f; for (int q = 0; q < 32; ++q) s += red[q * 128 + tid]; KMEAN[((size_t)bh * 8 + n) * 128 + tid] = s * (1.f / 256.f); }
        if (tid == 128) { float mx = 0.f; for (int q = 0; q < 32; ++q) mx = fmaxf(mx, red[4096 + q]); ((float*)(ws + WS_KMAX))[bh * 8 + n] = sqrtf(mx); }
        { const int d = tid & 127, tg = tid >> 7;
          for (int gi = 0; gi < 8; ++gi) { const int g = tg * 8 + gi, s32 = g >> 2, fq = g & 3; unsigned short e8[8];
#pragma unroll
              for (int j = 0; j < 8; ++j) { const int tok = 32 * s32 + (j < 4 ? 4 * fq + j : 16 + 4 * fq + (j - 4)); e8[j] = *(const unsigned short*)(vt + tok * 272 + 2 * d); }
              u32x4 o; o.x = e8[0] | ((unsigned)e8[1] << 16); o.y = e8[2] | ((unsigned)e8[3] << 16); o.z = e8[4] | ((unsigned)e8[5] << 16); o.w = e8[6] | ((unsigned)e8[7] << 16);
              *(u32x4*)(VT + ((size_t)bh * 128 + d) * SEQ + n * 256 + 8 * g) = o; } }
        __syncthreads();
    }
}

__device__ __forceinline__ void moba_unit(const Params& P, unsigned char* smem, int bh, int qb) {
    int tid_ = threadIdx.x; asm volatile("" : "+v"(tid_)); const int tid = tid_, lane = tid & 63, w = tid >> 6, fr = lane & 15, fq = lane >> 4; const int b = bh >> 2, h = bh & 3;
    unsigned char* ws = P.ws;
    const bf16_t* PROJ = (const bf16_t*)(ws + WS_BIG); const float* KMEAN = (const float*)(ws + WS_KMEAN); const bf16_t* VT = (const bf16_t*)(ws + WS_VT); bf16_t* MIXIN = (bf16_t*)(ws + WS_MIXIN);
    const int qrow0 = qb * 256 + 32 * w;
    bf16x8 qf[2][4];
#pragma unroll
    for (int rt = 0; rt < 2; ++rt)
#pragma unroll
        for (int ks = 0; ks < 4; ++ks) qf[rt][ks] = *(const bf16x8*)(PROJ + (size_t)(b * SEQ + qrow0 + 16 * rt + fr) * NPROJ + C_MQ + h * 128 + 32 * ks + 8 * fq);
    unsigned selmask[2];
    if (qb <= 3) { selmask[0] = selmask[1] = (1u << qb) - 1u; }
    else {
        bf16x8 kmf[4];
#pragma unroll
        for (int ks = 0; ks < 4; ++ks) { const float* src = KMEAN + ((size_t)bh * 8 + (fr & 7)) * 128 + 32 * ks + 8 * fq; const f32x4 a = *(const f32x4*)src, c = *(const f32x4*)(src + 4);
            u32x4 o; o.x = pk2(a[0], a[1]); o.y = pk2(a[2], a[3]); o.z = pk2(c[0], c[1]); o.w = pk2(c[2], c[3]); if (fr >= 8) o = (u32x4){0u, 0u, 0u, 0u};
            kmf[ks] = __builtin_bit_cast(bf16x8, o); }
#pragma unroll
        for (int rt = 0; rt < 2; ++rt) { f32x4 g = {0.f, 0.f, 0.f, 0.f};
#pragma unroll
            for (int ks = 0; ks < 4; ++ks) g = __builtin_amdgcn_mfma_f32_16x16x32_bf16(kmf[ks], qf[rt][ks], g, 0, 0, 0);
            float gv[8];
#pragma unroll
            for (int i = 0; i < 4; ++i) { gv[i] = __shfl(g[i], fr); gv[4 + i] = __shfl(g[i], 16 + fr); }
            unsigned msk = 0u;
#pragma unroll
            for (int rep = 0; rep < 3; ++rep) { float best = -INFINITY; int bi = 0;
#pragma unroll
                for (int n = 0; n < 8; ++n) { const bool ok = (n < qb) && !((msk >> n) & 1u) && (gv[n] > best); best = ok ? gv[n] : best; bi = ok ? n : bi; }
                msk |= 1u << bi; }
            selmask[rt] = msk; }
    }
    float bound[2];
    { float kmx = 0.f; const float* KM = (const float*)(ws + WS_KMAX) + bh * 8;
      { const f32x4 k0 = *(const f32x4*)KM, k1 = *(const f32x4*)(KM + 4); const float kv[8] = {k0[0], k0[1], k0[2], k0[3], k1[0], k1[1], k1[2], k1[3]};
#pragma unroll
        for (int n = 0; n < 8; ++n) kmx = (n <= qb) ? fmaxf(kmx, kv[n]) : kmx; }
#pragma unroll
      for (int rt = 0; rt < 2; ++rt) { float q2 = 0.f;
#pragma unroll
          for (int ks = 0; ks < 4; ++ks)
#pragma unroll
              for (int e = 0; e < 8; ++e) { const float qv = __uint_as_float((unsigned)(unsigned short)qf[rt][ks][e] << 16); q2 += qv * qv; }
          q2 += __shfl_xor(q2, 16); q2 += __shfl_xor(q2, 32);
          bound[rt] = fminf(sqrtf(q2) * kmx * (0.08838834764831845f * 1.4426950408889634f) * 1.0001f, 96.f); } }
    f32x4 O[2][8]; float lsum[2];
#pragma unroll
    for (int rt = 0; rt < 2; ++rt) { lsum[rt] = 0.f;
#pragma unroll
        for (int dt = 0; dt < 8; ++dt) O[rt][dt] = (f32x4){0.f, 0.f, 0.f, 0.f}; }
    const int ntiles = (qb + 1) * 4;
    const int krow0 = tid >> 4, kpc = tid & 15;
    const int vrow0 = tid >> 3, vpc = tid & 7;
    const bf16_t* kbase = PROJ + (size_t)(b * SEQ) * NPROJ + C_MK + h * 128 + 8 * kpc;
    const bf16_t* vbase = VT + (size_t)bh * 128 * SEQ + 8 * vpc;
    u32x4 st[4];
#define MOBA_LOAD(key0) do { st[0] = *(const u32x4*)(kbase + (size_t)((key0) + krow0) * NPROJ); st[1] = *(const u32x4*)(kbase + (size_t)((key0) + krow0 + 32) * NPROJ); \
        st[2] = *(const u32x4*)(vbase + (size_t)vrow0 * SEQ + (key0)); st[3] = *(const u32x4*)(vbase + (size_t)(vrow0 + 64) * SEQ + (key0)); } while (0)
#define MOBA_STORE(buf) do { unsigned char* kb_ = smem + (buf) * 35840; unsigned char* vb_ = kb_ + 17408; \
        *(u32x4*)(kb_ + krow0 * 272 + kpc * 16) = st[0]; *(u32x4*)(kb_ + (krow0 + 32) * 272 + kpc * 16) = st[1]; \
        *(u32x4*)(vb_ + vrow0 * 144 + vpc * 16) = st[2]; *(u32x4*)(vb_ + (vrow0 + 64) * 144 + vpc * 16) = st[3]; } while (0)
    MOBA_LOAD(0); MOBA_STORE(0);
    __syncthreads();
    const float SC = 0.08838834764831845f * 1.4426950408889634f;
    for (int tt = 0; tt < ntiles; ++tt) {
        const int n = tt >> 2, key0 = tt * 64; const int buf = tt & 1;
        if (tt + 1 < ntiles) MOBA_LOAD(key0 + 64);
        const unsigned char* kb = smem + buf * 35840; const unsigned char* vb = kb + 17408;
        f32x4 s[2][4];
#pragma unroll
        for (int rt = 0; rt < 2; ++rt)
#pragma unroll
            for (int kt = 0; kt < 4; ++kt) s[rt][kt] = (f32x4){0.f, 0.f, 0.f, 0.f};
        bf16x8 ga[4], gb[4];
#define LDK_(F, kt_) do { _Pragma("unroll") for (int ks_ = 0; ks_ < 4; ++ks_) F[ks_] = *(const bf16x8*)(kb + (16 * (kt_) + fr) * 272 + (32 * ks_ + 8 * fq) * 2); } while (0)
#define MMS_(F, kt_) do { _Pragma("unroll") for (int ks_ = 0; ks_ < 4; ++ks_) { s[0][kt_] = __builtin_amdgcn_mfma_f32_16x16x32_bf16(F[ks_], qf[0][ks_], s[0][kt_], 0, 0, 0); s[1][kt_] = __builtin_amdgcn_mfma_f32_16x16x32_bf16(F[ks_], qf[1][ks_], s[1][kt_], 0, 0, 0); } } while (0)
#define LDV_(F, sl_, d0_) do { _Pragma("unroll") for (int dd_ = 0; dd_ < 4; ++dd_) F[dd_] = *(const bf16x8*)(vb + (16 * ((d0_) + dd_) + fr) * 144 + (32 * (sl_) + 8 * fq) * 2); } while (0)
#define MMV_(F, sl_, d0_) do { _Pragma("unroll") for (int dd_ = 0; dd_ < 4; ++dd_) { O[0][(d0_) + dd_] = __builtin_amdgcn_mfma_f32_16x16x32_bf16(F[dd_], pf[0][sl_], O[0][(d0_) + dd_], 0, 0, 0); O[1][(d0_) + dd_] = __builtin_amdgcn_mfma_f32_16x16x32_bf16(F[dd_], pf[1][sl_], O[1][(d0_) + dd_], 0, 0, 0); } } while (0)
#define SB0_() __builtin_amdgcn_sched_barrier(0)
        LDK_(ga, 0); LDK_(gb, 1); SB0_();
        MMS_(ga, 0); SB0_(); LDK_(ga, 2); SB0_();
        MMS_(gb, 1); SB0_(); LDK_(gb, 3); SB0_();
        MMS_(ga, 2); SB0_(); LDV_(ga, 0, 0); SB0_();
        MMS_(gb, 3); SB0_(); LDV_(gb, 0, 4); SB0_();
        bf16x8 pf[2][2];
#pragma unroll
        for (int rt = 0; rt < 2; ++rt) {
            const int row_t = qrow0 + 16 * rt + fr;
            const bool rowsel = (n < qb) ? (((selmask[rt] >> n) & 1u) != 0u) : true;
            if (n == qb) {
#pragma unroll
                for (int kt = 0; kt < 4; ++kt)
#pragma unroll
                    for (int i = 0; i < 4; ++i) { const int key = key0 + 16 * kt + 4 * fq + i; if (key > row_t) s[rt][kt][i] = -INFINITY; }
            }
            const float msub = rowsel ? -bound[rt] : -INFINITY;
            float ps = 0.f;
#pragma unroll
            for (int kt = 0; kt < 4; ++kt)
#pragma unroll
                for (int i = 0; i < 4; ++i) { const float pv = __builtin_amdgcn_exp2f(fmaf(s[rt][kt][i], SC, msub)); s[rt][kt][i] = pv; ps += pv; }
            lsum[rt] += ps;
#pragma unroll
            for (int sl = 0; sl < 2; ++sl) { u32x4 o; o.x = pk2(s[rt][2 * sl][0], s[rt][2 * sl][1]); o.y = pk2(s[rt][2 * sl][2], s[rt][2 * sl][3]);
                o.z = pk2(s[rt][2 * sl + 1][0], s[rt][2 * sl + 1][1]); o.w = pk2(s[rt][2 * sl + 1][2], s[rt][2 * sl + 1][3]); pf[rt][sl] = __builtin_bit_cast(bf16x8, o); }
        }
        SB0_(); MMV_(ga, 0, 0); SB0_(); LDV_(ga, 1, 0); SB0_();
        MMV_(gb, 0, 4); SB0_(); LDV_(gb, 1, 4); SB0_();
        MMV_(ga, 1, 0); SB0_(); MMV_(gb, 1, 4); SB0_();
#undef LDK_
#undef MMS_
#undef LDV_
#undef MMV_
#undef SB0_
        if (tt + 1 < ntiles) MOBA_STORE(buf ^ 1);
        __syncthreads();
    }
#undef MOBA_LOAD
#undef MOBA_STORE
#pragma unroll
    for (int rt = 0; rt < 2; ++rt) { float l = lsum[rt]; l += __shfl_xor(l, 16); l += __shfl_xor(l, 32); const float inv = 1.f / l;
        bf16_t* orow = MIXIN + (size_t)(b * SEQ + qrow0 + 16 * rt + fr) * DM + 512 + h * 128 + 4 * fq;
#pragma unroll
        for (int dt = 0; dt < 8; ++dt) { u32x2 o; o.x = pk2(O[rt][dt][0] * inv, O[rt][dt][1] * inv); o.y = pk2(O[rt][dt][2] * inv, O[rt][dt][3] * inv); *(u32x2*)(orow + 16 * dt) = o; } }
}

constexpr size_t WS_LBUF = WS_U, WS_GLAST = WS_END, WS_BVT = WS_END + 8192;
constexpr size_t WS_END2 = WS_BVT + (size_t)2048 * 16384;
__device__ __forceinline__ unsigned bf1(float v) { return pk2(v, 0.f) & 0xffffu; }

__host__ __device__ constexpr int ltri_off(int i) { return i <= 0 ? 0 : (((i - 1) >> 2) + 1) * (2 * ((i - 1) >> 2) + ((i - 1) & 3)); }
__device__ __forceinline__ void gdn_prep(const Params& P, unsigned char* smem) {
    int tid_ = threadIdx.x; asm volatile("" : "+v"(tid_)); const int tid = tid_, lane = tid & 63, wave = tid >> 6, fr = lane & 15, fq = lane >> 4; unsigned char* ws = P.ws;
    const bf16_t* PROJ = (const bf16_t*)(ws + WS_BIG); const float* LG = (const float*)(ws + WS_LG); unsigned char* REC = (unsigned char*)P.out;
    bf16_t* BVT = (bf16_t*)(ws + WS_BVT); float* GLAST = (float*)(ws + WS_GLAST);
    unsigned char* Kb = smem; unsigned char* Qb = smem + 17408; unsigned char* Vb = smem + 34816;
    float* gsA = (float*)(smem + 52224); float* bsA = gsA + 512; float* esA = bsA + 512; float* egA = esA + 512;
    float* cwl = (float*)(smem + 60416);
    unsigned char* Lp = smem + 66560;
    const int p = tid & 15, rg = tid >> 4; const int G = gridDim.x; int hcur = -1;
    for (int k0 = 0; (int)blockIdx.x + k0 * G < 2048; k0 += 8) {
        { const int chunk = blockIdx.x + (k0 + wave) * G;
          if (chunk < 2048) { const int bh = chunk >> 5, n = chunk & 31, b = bh >> 2, h = bh & 3; const size_t m = (size_t)(b * SEQ + n * 64 + lane);
            const float gb = LG[m * 8 + h], ga = LG[m * 8 + 4 + h] + P.dt_bias[h];
            const float beta = 1.f / (1.f + __expf(-gb)); const float sp = ga > 20.f ? ga : log1pf(__expf(ga)); float g = -__expf(P.a_log[h]) * sp;
#pragma unroll
            for (int o = 1; o < 64; o <<= 1) { const float v = __shfl_up(g, o); if (lane >= o) g += v; }
            const float g63 = __shfl(g, 63);
            gsA[wave * 64 + lane] = g; bsA[wave * 64 + lane] = beta; esA[wave * 64 + lane] = __expf(g63 - g); egA[wave * 64 + lane] = __expf(g);
            if (lane == 63) GLAST[chunk] = __expf(g); } }
        __syncthreads();
        u32x4 ld[2][5];
        for (int ci = 0; ci < 8; ++ci) {
            const int chunk = blockIdx.x + (k0 + ci) * G; if (chunk >= 2048) break;
            const int bh = chunk >> 5, n = chunk & 31, b = bh >> 2, h = bh & 3, t0 = n * 64;
            unsigned char* rec = REC + (size_t)chunk * 65536;
            const float* gs = gsA + ci * 64; const float* bs = bsA + ci * 64; const float* es = esA + ci * 64; const float* eg = egA + ci * 64;
            if (h != hcur) { __syncthreads(); for (int i = tid; i < 1536; i += 512) { const int ten = i >> 9, tap = (i >> 7) & 3, c = i & 127; cwl[i] = P.conv_w[tap * 1536 + ten * 512 + h * 128 + c]; } hcur = h; __syncthreads(); }
#define CONV_LOAD(buf, ten_) do { _Pragma("unroll") for (int i_ = 0; i_ < 5; ++i_) { const int tt_ = t0 + 2 * rg - 3 + i_; \
                    ld[buf][i_] = *(const u32x4*)(PROJ + (size_t)(b * SEQ + max(tt_, 0)) * NPROJ + (ten_) * 512 + h * 128 + 8 * p); } } while (0)
            if (ci == 0) CONV_LOAD(0, 0);
#pragma unroll
            for (int ten = 0; ten < 3; ++ten) { float a0[8], a1[8];
                if (ten < 2) CONV_LOAD((ten + 1) & 1, ten + 1);
#pragma unroll
                for (int e = 0; e < 8; ++e) { a0[e] = 0.f; a1[e] = 0.f; }
#pragma unroll
                for (int i = 0; i < 5; ++i) { u32x4 w = ld[ten & 1][i]; if (t0 + 2 * rg - 3 + i < 0) w = (u32x4){0u, 0u, 0u, 0u}; const float xv[8] = {bflo(w.x), bfhi(w.x), bflo(w.y), bfhi(w.y), bflo(w.z), bfhi(w.z), bflo(w.w), bfhi(w.w)};
                    if (i < 4) { const f32x4 w0 = *(const f32x4*)(cwl + (ten * 4 + i) * 128 + 8 * p), w1 = *(const f32x4*)(cwl + (ten * 4 + i) * 128 + 8 * p + 4);
#pragma unroll
                        for (int e = 0; e < 4; ++e) { a0[e] += w0[e] * xv[e]; a0[4 + e] += w1[e] * xv[4 + e]; } }
                    if (i >= 1) { const f32x4 w0 = *(const f32x4*)(cwl + (ten * 4 + i - 1) * 128 + 8 * p), w1 = *(const f32x4*)(cwl + (ten * 4 + i - 1) * 128 + 8 * p + 4);
#pragma unroll
                        for (int e = 0; e < 4; ++e) { a1[e] += w0[e] * xv[e]; a1[4 + e] += w1[e] * xv[4 + e]; } } }
#pragma unroll
                for (int rr = 0; rr < 2; ++rr) { float* acc = rr == 0 ? a0 : a1; const int row = 2 * rg + rr; float ss = 0.f;
#pragma unroll
                    for (int e = 0; e < 8; ++e) { acc[e] = silu_f(acc[e]); ss += acc[e] * acc[e]; }
                    if (ten < 2) { ss += __shfl_xor(ss, 1); ss += __shfl_xor(ss, 2); ss += __shfl_xor(ss, 4); ss += __shfl_xor(ss, 8);
                        const float sc = rsqrtf(ss + RMS_EPS) * (ten == 0 ? 0.08838834764831845f : 1.f);
#pragma unroll
                        for (int e = 0; e < 8; ++e) acc[e] *= sc; }
                    u32x4 o; o.x = pk2(acc[0], acc[1]); o.y = pk2(acc[2], acc[3]); o.z = pk2(acc[4], acc[5]); o.w = pk2(acc[6], acc[7]);
                    *(u32x4*)((ten == 0 ? Qb : (ten == 1 ? Kb : Vb)) + row * 272 + 16 * p) = o;
                    if (ten < 2) { const float egr = eg[row]; const float f = (ten == 0) ? egr : egr * bs[row];
                        const int pp = p & 3, s1 = 16 * (pp & 1) + 4 * (pp >> 1);
                        unsigned char* rp = rec + (ten == 0 ? 16384 : 0) + row * 256 + (32 * (p >> 2)) * 2;
                        u32x2 q0, q1; q0.x = pk2(acc[0] * f, acc[1] * f); q0.y = pk2(acc[2] * f, acc[3] * f); q1.x = pk2(acc[4] * f, acc[5] * f); q1.y = pk2(acc[6] * f, acc[7] * f);
                        *(u32x2*)(rp + s1 * 2) = q0; *(u32x2*)(rp + (s1 + 8) * 2) = q1; } } }
            { const int chn = blockIdx.x + (k0 + ci + 1) * G;
              if (ci + 1 < 8 && chn < 2048) { const int bhn = chn >> 5, nn = chn & 31, bn = bhn >> 2, hn = bhn & 3;
#pragma unroll
                  for (int i_ = 0; i_ < 5; ++i_) { const int tt_ = nn * 64 + 2 * rg - 3 + i_;
                      ld[0][i_] = *(const u32x4*)(PROJ + (size_t)(bn * SEQ + max(tt_, 0)) * NPROJ + hn * 128 + 8 * p); } } }
            __syncthreads();
            { const int dcol = tid & 127, gp = tid >> 7;
#pragma unroll
              for (int q = 0; q < 2; ++q) { const int sg = gp * 2 + q, mp = sg >> 2, f4 = sg & 3; float kv[8], vv[8];
#pragma unroll
                  for (int jj = 0; jj < 8; ++jj) { const int c = 32 * mp + (jj < 4 ? 4 * f4 + jj : 16 + 4 * f4 + jj - 4);
                      kv[jj] = es[c] * __uint_as_float((unsigned)(*(const unsigned short*)(Kb + c * 272 + 2 * dcol)) << 16);
                      const int sr = 8 * sg + jj; vv[jj] = bs[sr] * __uint_as_float((unsigned)(*(const unsigned short*)(Vb + sr * 272 + 2 * dcol)) << 16); }
                  u32x4 o; o.x = pk2(kv[0], kv[1]); o.y = pk2(kv[2], kv[3]); o.z = pk2(kv[4], kv[5]); o.w = pk2(kv[6], kv[7]);
                  *(u32x4*)(rec + 32768 + dcol * 128 + sg * 16) = o;
                  u32x4 o2; o2.x = pk2(vv[0], vv[1]); o2.y = pk2(vv[2], vv[3]); o2.z = pk2(vv[4], vv[5]); o2.w = pk2(vv[6], vv[7]);
                  *(u32x4*)((unsigned char*)BVT + (size_t)chunk * 16384 + dcol * 128 + sg * 16) = o2; } }
            float* Lc = (float*)(Lp + ci * 8448);
            for (int job = wave; job < 26; job += 8) {
                if (job >= 20) { const int u = job - 20; const int it = (u < 3) ? 0 : (u < 5 ? 1 : 2); const int jt = (u < 3) ? u + 1 : (u < 5 ? u - 1 : 3);
                    const int i = 16 * it + fr; *(u32x2*)(rec + 57344 + i * 128 + (32 * (jt >> 1) + 8 * fq + 4 * (jt & 1)) * 2) = (u32x2){0u, 0u}; continue; }
                const int idx = job % 10; const bool isL = job < 10;
                const int it = (idx >= 6) ? 3 : (idx >= 3 ? 2 : (idx >= 1 ? 1 : 0)); const int jt = idx - it * (it + 1) / 2;
                const unsigned char* Xb = isL ? Kb : Qb;
                f32x4 d = {0.f, 0.f, 0.f, 0.f};
#pragma unroll
                for (int ks = 0; ks < 4; ++ks) { const bf16x8 kf = *(const bf16x8*)(Kb + (16 * jt + fr) * 272 + (32 * ks + 8 * fq) * 2), xf = *(const bf16x8*)(Xb + (16 * it + fr) * 272 + (32 * ks + 8 * fq) * 2);
                    d = __builtin_amdgcn_mfma_f32_16x16x32_bf16(kf, xf, d, 0, 0, 0); }
                const int i = 16 * it + fr; const float gi = gs[i], bi = bs[i]; float v[4];
#pragma unroll
                for (int e = 0; e < 4; ++e) { const int j = 16 * jt + 4 * fq + e; const bool ok = isL ? (j < i) : (j <= i); const float dec = __expf(fminf(gi - gs[j], 0.f)); v[e] = ok ? d[e] * dec * (isL ? bi : 1.f) : 0.f; }
                if (isL) { if (16 * jt + 4 * fq < ((i + 3) & ~3)) *(f32x4*)(Lc + 4 * ltri_off(i) + 16 * jt + 4 * fq) = (f32x4){v[0], v[1], v[2], v[3]}; }
                else { u32x2 o; o.x = pk2(v[0], v[1]); o.y = pk2(v[2], v[3]); *(u32x2*)(rec + 57344 + i * 128 + (32 * (jt >> 1) + 8 * fq + 4 * (jt & 1)) * 2) = o; }
            }
            __syncthreads();
        }
        { const int chunk = blockIdx.x + (k0 + wave) * G;
          if (chunk < 2048) { const float* Lc = (const float*)(Lp + wave * 8448);
              float Tc[64];
#pragma unroll
              for (int i = 0; i < 64; ++i) { float ac[4] = {(lane == i) ? 1.f : 0.f, 0.f, 0.f, 0.f};
#pragma unroll
                  for (int j4 = 0; j4 < (i + 3) / 4; ++j4) { const f32x4 l4 = *(const f32x4*)(Lc + 4 * ltri_off(i) + 4 * j4);
#pragma unroll
                      for (int e = 0; e < 4; ++e) if (4 * j4 + e < i) ac[e] -= l4[e] * Tc[4 * j4 + e]; }
                  Tc[i] = (ac[0] + ac[1]) + (ac[2] + ac[3]); if ((i & 3) == 3) __builtin_amdgcn_sched_barrier(0); }
              const int x = lane & 31; const int slot = 32 * (lane >> 5) + (x < 16 ? 8 * (x >> 2) + (x & 3) : 8 * ((x - 16) >> 2) + 4 + (x & 3));
              unsigned short* Tl = (unsigned short*)(Lp + wave * 8448);
#pragma unroll
              for (int i = 0; i < 64; ++i) Tl[i * 64 + slot] = (unsigned short)bf1(Tc[i]);
              unsigned char* trec = REC + (size_t)chunk * 65536 + 49152;
#pragma unroll
              for (int it = 0; it < 8; ++it) *(u32x4*)(trec + (it * 64 + lane) * 16) = *(const u32x4*)((const unsigned char*)Tl + (it * 64 + lane) * 16);
          } }
        __syncthreads();
    }
}

__device__ __forceinline__ void gdn_scan(const Params& P, unsigned char* smem, int bh) {
    int tid_ = threadIdx.x; asm volatile("" : "+v"(tid_)); const int tid = tid_, lane = tid & 63, w = tid >> 6, fr = lane & 15, fq = lane >> 4; const int b = bh >> 2, h = bh & 3; unsigned char* ws = P.ws;
    const bf16_t* PROJ = (const bf16_t*)(ws + WS_BIG); bf16_t* MIXIN = (bf16_t*)(ws + WS_MIXIN); const unsigned char* REC = (const unsigned char*)P.out;
    const unsigned char* BVT = (const unsigned char*)(ws + WS_BVT); const float* GLAST = (const float*)(ws + WS_GLAST);
    unsigned char* Lk = smem; unsigned char* Lq = smem + 17408; unsigned char* Lt = smem + 34816; unsigned char* LT = smem + 53248; unsigned char* Li = smem + 62464; float* Os = (float*)(smem + 71680);
    f32x4 Sacc[8];
#pragma unroll
    for (int j = 0; j < 8; ++j) Sacc[j] = (f32x4){0.f, 0.f, 0.f, 0.f};
    u32x4 st[8];
#define GS_LOAD(ch) do { const unsigned char* r_ = REC + (size_t)(ch) * 65536; _Pragma("unroll") for (int i_ = 0; i_ < 8; ++i_) st[i_] = *(const u32x4*)(r_ + (size_t)(tid + 512 * i_) * 16); } while (0)
#define GS_STORE() do { _Pragma("unroll") for (int i_ = 0; i_ < 8; ++i_) { const int id_ = tid + 512 * i_; unsigned char* d_; \
        if (i_ < 2) d_ = Lk + (id_ >> 4) * 272 + (id_ & 15) * 16; else if (i_ < 4) d_ = Lq + ((id_ - 1024) >> 4) * 272 + (id_ & 15) * 16; \
        else if (i_ < 6) d_ = Lt + ((id_ - 2048) >> 3) * 144 + (id_ & 7) * 16; else if (i_ < 7) d_ = LT + ((id_ - 3072) >> 3) * 144 + (id_ & 7) * 16; \
        else d_ = Li + ((id_ - 3584) >> 3) * 144 + (id_ & 7) * 16; *(u32x4*)d_ = st[i_]; } } while (0)
    u32x2 bvw[4]; float glast; unsigned zc[8];
    float nwv[16];
#pragma unroll
    for (int e = 0; e < 16; ++e) nwv[e] = P.gdn_norm_w[16 * (lane & 7) + e];
#define GS_BV(ch) do { glast = GLAST[ch]; _Pragma("unroll") for (int rt_ = 0; rt_ < 4; ++rt_) bvw[rt_] = *(const u32x2*)(BVT + (size_t)(ch) * 16384 + (16 * w + fr) * 128 + (16 * rt_ + 4 * fq) * 2); } while (0)
#define GS_Z(nn) do { const bf16_t* zp_ = PROJ + (size_t)(b * SEQ + (nn) * 64 + w * 8 + (lane >> 3)) * NPROJ + C_GZ + h * 128 + 16 * (lane & 7); const u32x4 za_ = *(const u32x4*)zp_, zb_ = *(const u32x4*)(zp_ + 8); \
          zc[0] = za_.x; zc[1] = za_.y; zc[2] = za_.z; zc[3] = za_.w; zc[4] = zb_.x; zc[5] = zb_.y; zc[6] = zb_.z; zc[7] = zb_.w; } while (0)
    GS_LOAD(bh * 32); GS_STORE(); GS_BV(bh * 32);
    __syncthreads();
    for (int n = 0; n < 32; ++n) {
        const int chunk = bh * 32 + n;
        GS_LOAD(bh * 32 + min(n + 1, 31)); GS_Z(n);
        bf16x8 sb[4];
#pragma unroll
        for (int m = 0; m < 4; ++m) { u32x4 o; o.x = pk2(Sacc[2 * m][0], Sacc[2 * m][1]); o.y = pk2(Sacc[2 * m][2], Sacc[2 * m][3]); o.z = pk2(Sacc[2 * m + 1][0], Sacc[2 * m + 1][1]); o.w = pk2(Sacc[2 * m + 1][2], Sacc[2 * m + 1][3]);
            sb[m] = __builtin_bit_cast(bf16x8, o); }
        bf16x8 fa[8], fb[8];
#define LD_KQ(F, rt_) do { _Pragma("unroll") for (int m_ = 0; m_ < 4; ++m_) { F[m_] = *(const bf16x8*)(Lk + (16 * (rt_) + fr) * 272 + (32 * m_ + 8 * fq) * 2); F[4 + m_] = *(const bf16x8*)(Lq + (16 * (rt_) + fr) * 272 + (32 * m_ + 8 * fq) * 2); } } while (0)
#define LD_64(F, base_) do { _Pragma("unroll") for (int rt_ = 0; rt_ < 4; ++rt_) _Pragma("unroll") for (int mp_ = 0; mp_ < 2; ++mp_) F[2 * rt_ + mp_] = *(const bf16x8*)((base_) + (16 * rt_ + fr) * 144 + (32 * mp_ + 8 * fq) * 2); } while (0)
#define LD_KT(F, j0_) do { _Pragma("unroll") for (int jj_ = 0; jj_ < 4; ++jj_) _Pragma("unroll") for (int mp_ = 0; mp_ < 2; ++mp_) F[2 * jj_ + mp_] = *(const bf16x8*)(Lt + (16 * ((j0_) + jj_) + fr) * 144 + (32 * mp_ + 8 * fq) * 2); } while (0)
#define MM_KQ(F, rt_) do { xacc[rt_] = (f32x4){0.f, 0.f, 0.f, 0.f}; oacc[rt_] = (f32x4){0.f, 0.f, 0.f, 0.f}; _Pragma("unroll") for (int m_ = 0; m_ < 4; ++m_) { \
            xacc[rt_] = __builtin_amdgcn_mfma_f32_16x16x32_bf16(F[m_], sb[m_], xacc[rt_], 0, 0, 0); oacc[rt_] = __builtin_amdgcn_mfma_f32_16x16x32_bf16(F[4 + m_], sb[m_], oacc[rt_], 0, 0, 0); } } while (0)
#define SB0() __builtin_amdgcn_sched_barrier(0)
        f32x4 xacc[4], oacc[4], vacc[4];
        LD_KQ(fa, 0); LD_KQ(fb, 1); SB0();
        MM_KQ(fa, 0); SB0(); LD_KQ(fa, 2); SB0();
        MM_KQ(fb, 1); SB0(); LD_KQ(fb, 3); SB0();
        MM_KQ(fa, 2); SB0(); LD_64(fa, LT); SB0();
        MM_KQ(fb, 3); SB0(); LD_64(fb, Li); SB0();
        bf16x8 xb[2];
#pragma unroll
        for (int mp = 0; mp < 2; ++mp) { float xv[8];
#pragma unroll
            for (int q = 0; q < 2; ++q) { const int rt = 2 * mp + q; xv[4 * q] = bflo(bvw[rt].x) - xacc[rt][0]; xv[4 * q + 1] = bfhi(bvw[rt].x) - xacc[rt][1]; xv[4 * q + 2] = bflo(bvw[rt].y) - xacc[rt][2]; xv[4 * q + 3] = bfhi(bvw[rt].y) - xacc[rt][3]; }
            u32x4 o; o.x = pk2(xv[0], xv[1]); o.y = pk2(xv[2], xv[3]); o.z = pk2(xv[4], xv[5]); o.w = pk2(xv[6], xv[7]); xb[mp] = __builtin_bit_cast(bf16x8, o); }
#pragma unroll
        for (int rt = 0; rt < 4; ++rt) { vacc[rt] = (f32x4){0.f, 0.f, 0.f, 0.f};
#pragma unroll
            for (int mp = 0; mp < 2; ++mp) vacc[rt] = __builtin_amdgcn_mfma_f32_16x16x32_bf16(fa[2 * rt + mp], xb[mp], vacc[rt], 0, 0, 0); }
        SB0(); LD_KT(fa, 0); SB0();
        bf16x8 vb[2];
#pragma unroll
        for (int mp = 0; mp < 2; ++mp) { u32x4 o; o.x = pk2(vacc[2 * mp][0], vacc[2 * mp][1]); o.y = pk2(vacc[2 * mp][2], vacc[2 * mp][3]); o.z = pk2(vacc[2 * mp + 1][0], vacc[2 * mp + 1][1]); o.w = pk2(vacc[2 * mp + 1][2], vacc[2 * mp + 1][3]);
            vb[mp] = __builtin_bit_cast(bf16x8, o); }
#pragma unroll
        for (int rt = 0; rt < 4; ++rt)
#pragma unroll
            for (int mp = 0; mp < 2; ++mp) oacc[rt] = __builtin_amdgcn_mfma_f32_16x16x32_bf16(fb[2 * rt + mp], vb[mp], oacc[rt], 0, 0, 0);
        SB0(); LD_KT(fb, 4); SB0();
#pragma unroll
        for (int jj = 0; jj < 4; ++jj) { Sacc[jj] = Sacc[jj] * glast;
#pragma unroll
            for (int mp = 0; mp < 2; ++mp) Sacc[jj] = __builtin_amdgcn_mfma_f32_16x16x32_bf16(fa[2 * jj + mp], vb[mp], Sacc[jj], 0, 0, 0); }
        SB0();
#pragma unroll
        for (int jj = 0; jj < 4; ++jj) { Sacc[4 + jj] = Sacc[4 + jj] * glast;
#pragma unroll
            for (int mp = 0; mp < 2; ++mp) Sacc[4 + jj] = __builtin_amdgcn_mfma_f32_16x16x32_bf16(fb[2 * jj + mp], vb[mp], Sacc[4 + jj], 0, 0, 0); }
#undef LD_KQ
#undef LD_64
#undef LD_KT
#undef MM_KQ
#undef SB0
#pragma unroll
        for (int rt = 0; rt < 4; ++rt)
#pragma unroll
            for (int i = 0; i < 4; ++i) Os[(16 * rt + 4 * fq + i) * 128 + 16 * w + fr] = oacc[rt][i];
        __syncthreads();
        GS_STORE();
        {
          const int row = w * 8 + (lane >> 3), cg = lane & 7; const size_t m = (size_t)(b * SEQ + n * 64 + row);
          float ov[16]; float ss = 0.f;
#pragma unroll
          for (int k4 = 0; k4 < 4; ++k4) { const f32x4 o4 = *(const f32x4*)(Os + row * 128 + 16 * cg + 4 * k4); ov[4 * k4] = o4[0]; ov[4 * k4 + 1] = o4[1]; ov[4 * k4 + 2] = o4[2]; ov[4 * k4 + 3] = o4[3];
              ss += (o4[0] * o4[0] + o4[1] * o4[1]) + (o4[2] * o4[2] + o4[3] * o4[3]); }
          ss += __shfl_xor(ss, 1); ss += __shfl_xor(ss, 2); ss += __shfl_xor(ss, 4);
          const float rstd = rsqrtf(ss * (1.f / 128.f) + RMS_EPS);
          unsigned ow[8];
#pragma unroll
          for (int e2 = 0; e2 < 8; ++e2) { const unsigned zw = zc[e2];
              ow[e2] = pk2(ov[2 * e2] * rstd * nwv[2 * e2] * silu_f(bflo(zw)), ov[2 * e2 + 1] * rstd * nwv[2 * e2 + 1] * silu_f(bfhi(zw))); }
          bf16_t* op = MIXIN + m * DM + h * 128 + 16 * cg;
          *(u32x4*)op = (u32x4){ow[0], ow[1], ow[2], ow[3]}; *(u32x4*)(op + 8) = (u32x4){ow[4], ow[5], ow[6], ow[7]}; }
        GS_BV(bh * 32 + min(n + 1, 31));
        __syncthreads();
    }
#undef GS_BV
#undef GS_Z
#undef GS_LOAD
#undef GS_STORE
}

struct RowBuf { u32x2 m[4]; u32x2 x[4]; };
__device__ __forceinline__ void rb_load(RowBuf& r, const bf16_t* mb, const bf16_t* xb, int m, int lane) {
#pragma unroll
    for (int jj = 0; jj < 4; ++jj) { r.m[jj] = *(const u32x2*)(mb + (size_t)m * DM + 4 * lane + 256 * jj); r.x[jj] = *(const u32x2*)(xb + (size_t)m * DM + 4 * lane + 256 * jj); }
}
__device__ __forceinline__ void rp1_proc(const Params& P, const RowBuf& cur, int m, int lane, const f32x4 (&w1)[4], float* RS2) {
    f32x4 mv[4], xv[4]; float s = 0.f;
#pragma unroll
    for (int jj = 0; jj < 4; ++jj) { mv[jj] = (f32x4){bflo(cur.m[jj].x), bfhi(cur.m[jj].x), bflo(cur.m[jj].y), bfhi(cur.m[jj].y)}; xv[jj] = (f32x4){bflo(cur.x[jj].x), bfhi(cur.x[jj].x), bflo(cur.x[jj].y), bfhi(cur.x[jj].y)};
        s += (mv[jj][0] * mv[jj][0] + mv[jj][1] * mv[jj][1]) + (mv[jj][2] * mv[jj][2] + mv[jj][3] * mv[jj][3]); }
    const float r1 = rsqrtf(wave_sum(s) * (1.f / DM) + RMS_EPS); float s2 = 0.f;
#pragma unroll
    for (int jj = 0; jj < 4; ++jj) { xv[jj] = xv[jj] + mv[jj] * r1 * w1[jj]; { u32x2 hb; hb.x = pk2(xv[jj][0], xv[jj][1]); hb.y = pk2(xv[jj][2], xv[jj][3]); *(u32x2*)((bf16_t*)P.out + (size_t)m * DM + 4 * lane + 256 * jj) = hb; }
        s2 += (xv[jj][0] * xv[jj][0] + xv[jj][1] * xv[jj][1]) + (xv[jj][2] * xv[jj][2] + xv[jj][3] * xv[jj][3]); }
    const float r2 = rsqrtf(wave_sum(s2) * (1.f / DM) + RMS_EPS);
    if (lane == 0) RS2[m] = r2;
}
__device__ __forceinline__ void rowpass1(const Params& P) {
    int tid_ = threadIdx.x; asm volatile("" : "+v"(tid_)); const int tid = tid_, lane = tid & 63, wave = __builtin_amdgcn_readfirstlane(tid >> 6); const int gw = blockIdx.x * 8 + wave, NGW = gridDim.x * 8; unsigned char* ws = P.ws;
    const bf16_t* MIX = (const bf16_t*)(ws + WS_BIG); const bf16_t* XB = (const bf16_t*)(ws + WS_U); float* RS2 = (float*)(ws + WS_RS2);
    f32x4 w1[4];
#pragma unroll
    for (int jj = 0; jj < 4; ++jj) w1[jj] = *((const f32x4*)P.n_post_attn + lane + 64 * jj);
#define RP1_LOAD(buf, mm) rb_load(buf, MIX, XB, mm, lane)
#define RP1_PROC(buf, mm) rp1_proc(P, buf, mm, lane, w1, RS2)
    ROWLOOP3(RowBuf, RP1_LOAD, RP1_PROC);
#undef RP1_LOAD
#undef RP1_PROC
}
struct RowBuf2 { u32x2 m[4]; u32x2 h[4]; };
__device__ __forceinline__ void rb2_load(RowBuf2& r, const bf16_t* mb, const bf16_t* hb, int m, int lane) {
#pragma unroll
    for (int jj = 0; jj < 4; ++jj) { r.m[jj] = *(const u32x2*)(mb + (size_t)m * DM + 4 * lane + 256 * jj); r.h[jj] = *(const u32x2*)(hb + (size_t)m * DM + 4 * lane + 256 * jj); }
}
__device__ __forceinline__ void rp2_proc(const RowBuf2& cur, int m, int lane, const f32x4 (&w1)[4], bf16_t* H2B) {
    f32x4 fv[4], hv[4]; float s = 0.f;
#pragma unroll
    for (int jj = 0; jj < 4; ++jj) { fv[jj] = (f32x4){bflo(cur.m[jj].x), bfhi(cur.m[jj].x), bflo(cur.m[jj].y), bfhi(cur.m[jj].y)}; hv[jj] = (f32x4){bflo(cur.h[jj].x), bfhi(cur.h[jj].x), bflo(cur.h[jj].y), bfhi(cur.h[jj].y)};
        s += (fv[jj][0] * fv[jj][0] + fv[jj][1] * fv[jj][1]) + (fv[jj][2] * fv[jj][2] + fv[jj][3] * fv[jj][3]); }
    const float r1 = rsqrtf(wave_sum(s) * (1.f / DM) + RMS_EPS);
#pragma unroll
    for (int jj = 0; jj < 4; ++jj) { hv[jj] = hv[jj] + fv[jj] * r1 * w1[jj];
        u32x2 o; o.x = pk2(hv[jj][0], hv[jj][1]); o.y = pk2(hv[jj][2], hv[jj][3]); *(u32x2*)(H2B + (size_t)m * DM + 4 * lane + 256 * jj) = o; }
}
__device__ __forceinline__ void rowpass2(const Params& P) {
    int tid_ = threadIdx.x; asm volatile("" : "+v"(tid_)); const int tid = tid_, lane = tid & 63, wave = __builtin_amdgcn_readfirstlane(tid >> 6); const int gw = blockIdx.x * 8 + wave, NGW = gridDim.x * 8; unsigned char* ws = P.ws;
    const bf16_t* F = (const bf16_t*)(ws + WS_U); bf16_t* H2B = (bf16_t*)(ws + WS_MIXIN); const bf16_t* H1B = (const bf16_t*)P.out;
    f32x4 w1[4];
#pragma unroll
    for (int jj = 0; jj < 4; ++jj) w1[jj] = *((const f32x4*)P.n_post_mlp + lane + 64 * jj);
#define RP2_LOAD(buf, mm) rb2_load(buf, F, H1B, mm, lane)
#define RP2_PROC(buf, mm) rp2_proc(buf, mm, lane, w1, H2B)
    ROWLOOP3(RowBuf2, RP2_LOAD, RP2_PROC);
#undef RP2_LOAD
#undef RP2_PROC
}

template <int MODE> __device__ __forceinline__ void run_gemm(unsigned char* smem, const bf16_t* A, const bf16_t* Bt, int N, int K, bf16_t* O, int ldc, float* out, const bf16_t* ple, const float* rs = nullptr) {
    pg8::Gemm g{A, Bt, MTOK, N, K}; pg8::StaticOrder S; S.init(MTOK, N, (int)gridDim.x, (int)blockIdx.x);
    pg8::EpiGen<MODE> E{O, ldc, out, ple, rs};
#ifndef NO_GEMM
    pg8::gemm_phase<pg8::EpiGen<MODE>, pg8::StaticOrder, true, true>((PG8_LAS unsigned char*)smem, g, S, E);
#endif
    __syncthreads();
}

#define XB_TMO      128
#define XB_XCNT(j)  (256  + 64 * (j))
#define XB_XSUB(j)  (1280 + 64 * (j))
#define XB_XGEN(j)  (2304 + 64 * (j))
#define XB_TOP      3328
#define XB_TOPGEN   3392
#define XCD_BAR_WORDS 3456
#define XB_SPIN_CAP (1u << 18)

__device__ __forceinline__ unsigned xb_ld(unsigned* p)              { return __hip_atomic_load(p, __ATOMIC_RELAXED, __HIP_MEMORY_SCOPE_AGENT); }
__device__ __forceinline__ unsigned xb_add(unsigned* p, unsigned v) { return __hip_atomic_fetch_add(p, v, __ATOMIC_RELAXED, __HIP_MEMORY_SCOPE_AGENT); }
__device__ __forceinline__ unsigned xb_xcc_id() { return (unsigned)__builtin_amdgcn_s_getreg((3 << 11) | 20) & 0xFu; }
#define XB_SPIN(cond, bar) do { unsigned _sp = 0; while (cond) { __builtin_amdgcn_s_sleep(1); \
    if ((++_sp & 255u) == 0u) { if (xb_ld(&(bar)[XB_TMO])) break; if (_sp > XB_SPIN_CAP) { atomicAdd(&(bar)[XB_TMO], 1u); break; } } } } while (0)

struct XcdBarrier {
    unsigned* bar; unsigned x;
    volatile LAS unsigned* st;
};

__device__ __forceinline__ XcdBarrier xcd_barrier_post(unsigned* bar, volatile LAS unsigned* st) {
    XcdBarrier b; b.bar = bar; b.x = xb_xcc_id(); b.st = st;
    if (threadIdx.x == 0) (void)xb_add(&bar[XB_XCNT(b.x)], 1u);
    return b;
}
__device__ __forceinline__ void xcd_barrier_complete(unsigned* bar, unsigned x, unsigned& nloc, unsigned& nx) {
    const unsigned G = gridDim.x * gridDim.y * gridDim.z;
    unsigned sum, cnt, mine, sp = 0u;
    for (;;) {
        sum = 0u; cnt = 0u; mine = 0u;
#pragma unroll
        for (unsigned j = 0; j < 16; ++j) { const unsigned c = xb_ld(&bar[XB_XCNT(j)]); sum += c; cnt += (c > 0u) ? 1u : 0u; mine = (j == x) ? c : mine; }
        if (sum == G) break;
        __builtin_amdgcn_s_sleep(1);
        if ((++sp & 255u) == 0u) { if (xb_ld(&bar[XB_TMO])) break; if (sp > XB_SPIN_CAP) { atomicAdd(&bar[XB_TMO], 1u); break; } }
    }
    nloc = mine > 0u ? mine : 1u; nx = cnt > 0u ? cnt : 1u;
}

__device__ __forceinline__ void xcd_barrier(const XcdBarrier& b) {
    asm volatile("s_waitcnt vmcnt(0)" ::: "memory");
    __syncthreads();
    if (threadIdx.x == 0) {
        unsigned* bar = b.bar;
        __builtin_amdgcn_s_waitcnt(0);
        unsigned nloc = b.st[0], nx = b.st[1];
        if (nloc == 0u) { xcd_barrier_complete(bar, b.x, nloc, nx); b.st[0] = nloc; b.st[1] = nx; }
        const unsigned old = xb_add(&bar[XB_XSUB(b.x)], 1u);
        const unsigned gen = old / nloc;
        if (old + 1u == (gen + 1u) * nloc) {
            __builtin_amdgcn_fence(__ATOMIC_RELEASE, "agent");
            asm volatile("s_waitcnt vmcnt(0)" ::: "memory");
            const unsigned og = xb_add(&bar[XB_TOP], 1u);
            const unsigned tg = og / nx;
            if (og + 1u == (tg + 1u) * nx) xb_add(&bar[XB_TOPGEN], 1u);
            else XB_SPIN(xb_ld(&bar[XB_TOPGEN]) == tg, bar);
            __builtin_amdgcn_fence(__ATOMIC_ACQUIRE, "agent");
            xb_add(&bar[XB_XGEN(b.x)], 1u);
            asm volatile("s_waitcnt vmcnt(0)" ::: "memory");
        } else {
            XB_SPIN(xb_ld(&bar[XB_XGEN(b.x)]) == gen, bar);
            __builtin_amdgcn_fence(__ATOMIC_ACQUIRE, "agent");
            asm volatile("s_waitcnt vmcnt(0)" ::: "memory");
        }
    }
    __syncthreads();
}

constexpr size_t WS_XBAR = WS_END2 + 256;

constexpr size_t WS_TS = WS_END2;
#ifdef PROBE_K
#define STAMP(k) do { if (blockIdx.x == 0 && threadIdx.x == 0) ((unsigned long long*)(ws + WS_TS))[k] = __builtin_amdgcn_s_memrealtime(); } while (0)
#else
#define STAMP(k) do { } while (0)
#endif
#define XSYNC() xcd_barrier(xbar)
#define GRID_SYNC() do { asm volatile("s_waitcnt vmcnt(0)" ::: "memory"); grid.sync(); } while (0)
__global__ void __launch_bounds__(512) fwd_megakernel(Params P) {
    extern __shared__ __attribute__((aligned(16))) unsigned char smem[];
    cg::grid_group grid = cg::this_grid();
    unsigned char* ws = P.ws;
    volatile LAS unsigned* xst = (volatile LAS unsigned*)((LAS unsigned char*)smem + LDS_BYTES);
    if (threadIdx.x < 2) xst[threadIdx.x] = 0u;
    __syncthreads();
    const XcdBarrier xbar = xcd_barrier_post((unsigned*)(ws + WS_XBAR), xst);
    STAMP(0);
    phase0(P, smem);
#ifdef DUP_P0
    __syncthreads(); phase0(P, smem);
#endif
    XSYNC(); if (P.coop_marker) { GRID_SYNC(); }     STAMP(1);
    run_gemm<4>(smem, (const bf16_t*)(ws + WS_U), (const bf16_t*)(ws + WS_WIN), NPROJ, DM, (bf16_t*)(ws + WS_BIG), NPROJ, nullptr, nullptr, (const float*)(ws + WS_RS0));
    XSYNC(); STAMP(2);
    moba_prep(P, smem);
    gdn_prep(P, smem);
#ifdef DUP_PREP
    __syncthreads(); gdn_prep(P, smem);
#endif
    XSYNC(); STAMP(3);
#ifndef NDUP3
#define NDUP3 1
#endif
    for (int dup3 = 0; dup3 < NDUP3; ++dup3) { const int G = gridDim.x; const int ngdn = 64;
      if (dup3 > 0) { XSYNC(); }
      if ((int)blockIdx.x < ngdn) {
#ifndef NO_GDN
 for (int bh = blockIdx.x; bh < 64; bh += ngdn) gdn_scan(P, smem, bh);
#ifdef DUP_SCAN
 for (int bh = blockIdx.x; bh < 64; bh += ngdn) gdn_scan(P, smem, bh);
#endif
#endif
 }
      else { for (int u = blockIdx.x - ngdn; u < 192; u += G - ngdn) { const int bh = u / 3, j = u - 3 * bh;
#ifndef NO_MOBA
 const int nq = (j == 2) ? 4 : 2; const unsigned list = (j == 0) ? 0x37u : (j == 1 ? 0x46u : 0x0125u);
 for (int rep = 0; rep < nq; ++rep) moba_unit(P, smem, bh, (int)((list >> (4 * (nq - 1 - rep))) & 15u));
#ifdef DUP_MOBA
 for (int rep = 0; rep < nq; ++rep) moba_unit(P, smem, bh, (int)((list >> (4 * (nq - 1 - rep))) & 15u));
#endif
#endif
 } } }
    XSYNC(); STAMP(4);
    run_gemm<0>(smem, (const bf16_t*)(ws + WS_MIXIN), (const bf16_t*)(ws + WS_WOUT), DM, DM, (bf16_t*)(ws + WS_BIG), DM, nullptr, nullptr);
    XSYNC(); STAMP(5);
#ifdef DUP_SYNC
    for (int i_ = 0; i_ < 8; ++i_) { XSYNC(); }
#endif
    rowpass1(P);
#ifdef DUP_RP1
    rowpass1(P);
#endif
    XSYNC(); STAMP(6);
    run_gemm<5>(smem, (const bf16_t*)P.out, (const bf16_t*)(ws + WS_WUP), DFF, DM, (bf16_t*)(ws + WS_BIG), DFF, nullptr, nullptr, (const float*)(ws + WS_RS2));
    XSYNC(); STAMP(7);
    run_gemm<0>(smem, (const bf16_t*)(ws + WS_BIG), (const bf16_t*)(ws + WS_WDOWN), DM, DFF, (bf16_t*)(ws + WS_U), DM, nullptr, nullptr);
    XSYNC(); STAMP(8);
    rowpass2(P);
    run_gemm<0>(smem, (const bf16_t*)(ws + WS_PB), (const bf16_t*)(ws + WS_WPLE), DM, PLED, (bf16_t*)(ws + WS_BIG), DM, nullptr, nullptr);
    XSYNC(); STAMP(9);
    run_gemm<2>(smem, (const bf16_t*)(ws + WS_MIXIN), (const bf16_t*)(ws + WS_WGATE), DM, DM, (bf16_t*)(ws + WS_MIXIN), DM, P.out, (const bf16_t*)(ws + WS_BIG));
#ifdef PROBE_K
    XSYNC(); STAMP(10);
    if (blockIdx.x == 0 && threadIdx.x == 0) { const unsigned long long* ts = (const unsigned long long*)(ws + WS_TS); const float d0 = (float)(ts[PROBE_K + 1] - ts[PROBE_K]) * 0.01f, d1 = (float)(ts[PROBE_K2 + 1] - ts[PROBE_K2]) * 0.01f; P.out[0] = __expf(rintf(__logf(d0) * 4.f) * 0.25f); P.out[1] = __expf(rintf(__logf(d1) * 4.f) * 0.25f); }
#endif
}

extern "C" void kernel_launch(void* const* d_in, const int* in_sizes, int n_in, void* d_out, int out_size, void* d_ws, size_t ws_size, hipStream_t stream) {
    static int grid_blocks = 0;
    if (grid_blocks == 0) {
        if (ws_size < WS_TOTAL) { fprintf(stderr, "kernel_launch: workspace too small: %zu < %zu\n", ws_size, (size_t)WS_END2); grid_blocks = -1; return; }
        int dev = 0, cus = 0, per_cu = 0;
        hipGetDevice(&dev); hipDeviceGetAttribute(&cus, hipDeviceAttributeMultiprocessorCount, dev);
        hipFuncSetAttribute((const void*)fwd_megakernel, hipFuncAttributeMaxDynamicSharedMemorySize, LDS_BYTES + 64);
        hipOccupancyMaxActiveBlocksPerMultiprocessor(&per_cu, (const void*)fwd_megakernel, 512, LDS_BYTES + 64);
        if (per_cu < 1) { fprintf(stderr, "kernel_launch: occupancy query says %d blocks per CU\n", per_cu); per_cu = 1; }
        grid_blocks = cus;
        if (grid_blocks > 256) grid_blocks = 256;
    }
    if (grid_blocks < 0) return;
    Params P{};
    P.x = (const float*)d_in[0]; P.p = (const float*)d_in[1]; P.w_in = (const float*)d_in[2]; P.conv_w = (const float*)d_in[3]; P.a_log = (const float*)d_in[4]; P.dt_bias = (const float*)d_in[5];
    P.gdn_norm_w = (const float*)d_in[6]; P.w_out = (const float*)d_in[7]; P.n_pre_attn = (const float*)d_in[8]; P.n_post_attn = (const float*)d_in[9]; P.n_pre_mlp = (const float*)d_in[10];
    P.n_post_mlp = (const float*)d_in[11]; P.w_up = (const float*)d_in[12]; P.w_down = (const float*)d_in[13]; P.w_ple = (const float*)d_in[14]; P.w_gate = (const float*)d_in[15];
    P.out = (float*)d_out; P.ws = (unsigned char*)d_ws;
    for (int d = 0; d < 16; ++d) P.inv_freq[d] = (float)std::pow(500000.0, -(double)d / 16.0);
#ifdef DIAG_POISON
    hipMemsetAsync(d_out, 0xFF, (size_t)MTOK * DM * 4, stream);
    hipMemsetAsync((unsigned char*)d_ws + WS_U, 0xFF, (size_t)MTOK * DM * 2, stream);
    hipMemsetAsync((unsigned char*)d_ws + WS_GLAST, 0xFF, 8192, stream);
#endif
    hipMemsetAsync((unsigned char*)d_ws + WS_XBAR, 0, XCD_BAR_WORDS * 4, stream);
    void* args[] = {&P};
    hipError_t e = hipLaunchCooperativeKernel((const void*)fwd_megakernel, dim3(grid_blocks), dim3(512), args, LDS_BYTES + 64, stream);
    if (e != hipSuccess) fprintf(stderr, "cooperative launch failed: %s (grid %d)\n", hipGetErrorString(e), grid_blocks);
}
```

```cpp
#include <hip/hip_runtime.h>
#include <hip/hip_cooperative_groups.h>
#include <cstdio>
#include <cstdint>
#include <cmath>
namespace cg = cooperative_groups;
namespace pg8 {
#define PG8_LAS __attribute__((address_space(3)))
typedef unsigned short bf16_t;
typedef short bf16x8 __attribute__((ext_vector_type(8)));
typedef float f32x4 __attribute__((ext_vector_type(4)));
typedef unsigned u32x4 __attribute__((ext_vector_type(4)));
constexpr int BM = 256, BK = 64, HALF = 128, HTB = HALF * BK * 2  , STAGE_BYTES = 8 * HTB, NXCD = 8, WGM = 8;

__host__ __device__ __forceinline__ int lds_byte(int r, int c) { const int st = (r >> 4) * 2 + (c >> 5), rr = r & 15, cc = c & 31, ob = rr * 64 + cc * 2; return st * 1024 + (ob ^ (((ob >> 9) & 1) << 5)); }
__host__ __device__ __forceinline__ void stage_rc(int b, int& R, int& C) { const int st = b / 1024, sb = b % 1024, swz = sb ^ (((sb >> 9) & 1) << 5); R = (st >> 1) * 16 + swz / 64; C = (st & 1) * 32 + (swz % 64) / 2; }
__host__ __device__ __forceinline__ int perm32(int rho) { const int n = rho >> 4, i = rho & 15; return 8 * (i >> 2) + 4 * n + (i & 3); }

struct Unit { int pm, pn; };
struct Gemm { const bf16_t* A; const bf16_t* Bt; int M, N, K; };

struct StaticOrder {
    int nM, nN, nwg, G, c;
    __host__ __device__ void init(int M, int N, int G_, int c_) { nM = M / BM; nN = N / BM; nwg = nM * nN; G = G_; c = c_; }
    __host__ __device__ bool next(int i, Unit& u) const {
        const long L = (long)i * G + c; if (L >= nwg) return false;
        int wgid = (int)L; { const int q = nwg / NXCD, r = nwg % NXCD, xcd = wgid % NXCD, off = wgid / NXCD; wgid = (xcd < r ? xcd * (q + 1) : r * (q + 1) + (xcd - r) * q) + off; }
        const int nig = WGM * nN, gid = wgid / nig, fm = gid * WGM, gsz = (nM - fm) < WGM ? (nM - fm) : WGM;
        u.pm = fm + ((wgid % nig) % gsz); u.pn = (wgid % nig) / gsz; return true;
    }
    __device__ __forceinline__ void a_ready(const Unit&) const {}
    __device__ __forceinline__ void done(const Unit&) const {}
};

typedef __bf16 bf16x2_cv __attribute__((ext_vector_type(2)));
typedef float f32x2_cv __attribute__((ext_vector_type(2)));
__device__ __forceinline__ unsigned cvt_pk_bf16(float lo, float hi) { f32x2_cv v = {lo, hi}; bf16x2_cv b = __builtin_convertvector(v, bf16x2_cv); return __builtin_bit_cast(unsigned, b); }
template <int MODE> struct EpiGen {
    static constexpr bool PERM = true, AFTER_DRAIN = false;
    bf16_t* O; int ldc; float* out; const bf16_t* ple; const float* rs;
    __device__ __forceinline__ void operator()(const f32x4 (&acc)[2][2][4][2], const Unit& u, int wr, int wc, int fr, int fq) const {
        const int row0 = u.pm * BM + wr * 64 + fr; const int col0 = u.pn * BM + wc * 32 + 8 * fq;
        if (MODE == 2) {
#pragma unroll
            for (int ai = 0; ai < 2; ++ai) {
                f32x4 h0[4][2], h1[4][2]; u32x4 pw[4][2];
#pragma unroll
                for (int m = 0; m < 4; ++m)
#pragma unroll
                    for (int bj = 0; bj < 2; ++bj) { const size_t row = (size_t)(row0 + ai * HALF + m * 16); const int col = col0 + bj * HALF;
                        const u32x4 hw = *(const u32x4*)(O + row * 1024 + col);
                        h0[m][bj] = (f32x4){__uint_as_float(hw.x << 16), __uint_as_float(hw.x & 0xffff0000u), __uint_as_float(hw.y << 16), __uint_as_float(hw.y & 0xffff0000u)};
                        h1[m][bj] = (f32x4){__uint_as_float(hw.z << 16), __uint_as_float(hw.z & 0xffff0000u), __uint_as_float(hw.w << 16), __uint_as_float(hw.w & 0xffff0000u)};
                        pw[m][bj] = *(const u32x4*)(ple + row * 1024 + col); }
#pragma unroll
                for (int m = 0; m < 4; ++m)
#pragma unroll
                    for (int bj = 0; bj < 2; ++bj) { const size_t row = (size_t)(row0 + ai * HALF + m * 16); const int col = col0 + bj * HALF; float* op = out + row * 1024 + col;
                        const f32x4 v0 = acc[ai][bj][m][0], v1 = acc[ai][bj][m][1]; const u32x4 w = pw[m][bj];
                        const f32x4 p0 = {__uint_as_float(w.x << 16), __uint_as_float(w.x & 0xffff0000u), __uint_as_float(w.y << 16), __uint_as_float(w.y & 0xffff0000u)};
                        const f32x4 p1 = {__uint_as_float(w.z << 16), __uint_as_float(w.z & 0xffff0000u), __uint_as_float(w.w << 16), __uint_as_float(w.w & 0xffff0000u)};
                        f32x4 o0, o1;
#pragma unroll
                        for (int e = 0; e < 4; ++e) { o0[e] = h0[m][bj][e] + p0[e] * __builtin_amdgcn_rcpf(1.f + __expf(-v0[e])); o1[e] = h1[m][bj][e] + p1[e] * __builtin_amdgcn_rcpf(1.f + __expf(-v1[e])); }
                        *(f32x4*)op = o0; *(f32x4*)(op + 4) = o1; }
            }
            return;
        }
        float rsv[2][4];
#pragma unroll
        for (int ai = 0; ai < 2; ++ai)
#pragma unroll
            for (int m = 0; m < 4; ++m) rsv[ai][m] = (MODE == 4 || MODE == 5) ? rs[row0 + ai * HALF + m * 16] : 1.f;
#pragma unroll
        for (int ai = 0; ai < 2; ++ai)
#pragma unroll
            for (int m = 0; m < 4; ++m) {
                const size_t row = (size_t)(row0 + ai * HALF + m * 16);
                float rsc = 1.f; if (MODE == 4) rsc = rsv[ai][m]; if (MODE == 5) rsc = rsv[ai][m] * rsv[ai][m];
#pragma unroll
                for (int bj = 0; bj < 2; ++bj) {
                    f32x4 v0 = acc[ai][bj][m][0], v1 = acc[ai][bj][m][1];
                    const int col = col0 + bj * HALF;
                    if (MODE == 1 || MODE == 5) {
#pragma unroll
                        for (int e = 0; e < 4; ++e) { float a = fmaxf(v0[e], 0.f), b = fmaxf(v1[e], 0.f); v0[e] = a * a; v1[e] = b * b; }
                    }
                    if (MODE == 4 || MODE == 5) { v0 = v0 * rsc; v1 = v1 * rsc; }
                    u32x4 w; w.x = cvt_pk_bf16(v0[0], v0[1]); w.y = cvt_pk_bf16(v0[2], v0[3]); w.z = cvt_pk_bf16(v1[0], v1[1]); w.w = cvt_pk_bf16(v1[2], v1[3]);
                    *(u32x4*)(O + row * ldc + col) = w;
                }
            }
    }
};
template <class Epi, class Sched, bool ALIGN_EPI = false, bool SP2 = false>
__device__ __forceinline__ void gemm_phase(PG8_LAS unsigned char* lds, const Gemm g, const Sched& S, const Epi& E) {
    int tid_ = threadIdx.x; asm volatile("" : "+v"(tid_)); const int tid = tid_, wid = __builtin_amdgcn_readfirstlane(tid >> 6), lane = tid & 63, wr = wid >> 2, wc = wid & 3, fr = lane & 15, fq = lane >> 4;
    const int K = g.K, nt = K / BK;
    unsigned voffA[2], voffB[2];
#pragma unroll
    for (int i = 0; i < 2; ++i) { int R, C; stage_rc(tid * 16 + i * 8192, R, C); const int Rb = Epi::PERM ? ((R & ~31) + perm32(R & 31)) : R;
        voffA[i] = (unsigned)(R * K + C) * 2u; voffB[i] = (unsigned)(Rb * K + C) * 2u; }
    const size_t kstep = (size_t)(BK * 2);
    const size_t hstep = (size_t)HALF * K * 2;
    const size_t tstep = 2 * hstep;
    const unsigned ldsw = (unsigned)wid * 1024u;
    const int aoff = lds_byte(wr * 64 + fr, fq * 8), boff = lds_byte(wc * 32 + fr, fq * 8);
#define PG8_SA(b, h) (((b) * 2 + (h)) * HTB)
#define PG8_SB(b, h) ((4 + (b) * 2 + (h)) * HTB)
#define PG8_STAGE(bufoff, gbase, voff) do { _Pragma("unroll") for (int _i = 0; _i < 2; ++_i) \
        __builtin_amdgcn_global_load_lds((const unsigned*)((const char*)(gbase) + (voff)[_i]), (PG8_LAS unsigned*)(lds + (bufoff) + ldsw + _i * 8192), 16, 0, 0); } while (0)
#define PG8_LDA(dst, b, h) do { _Pragma("unroll") for (int m = 0; m < 4; ++m) _Pragma("unroll") for (int k = 0; k < 2; ++k) dst[m][k] = *(const PG8_LAS bf16x8*)(lds + PG8_SA(b, h) + aoff + m * 2048 + k * 1024); } while (0)
#define PG8_LDB(dst, b, h) do { _Pragma("unroll") for (int n = 0; n < 2; ++n) _Pragma("unroll") for (int k = 0; k < 2; ++k) dst[n][k] = *(const PG8_LAS bf16x8*)(lds + PG8_SB(b, h) + boff + n * 2048 + k * 1024); } while (0)
#define PG8_MMA(ai, bj, At, Bt) do { __builtin_amdgcn_s_setprio(1); _Pragma("unroll") for (int m = 0; m < 4; ++m) _Pragma("unroll") for (int n = 0; n < 2; ++n) _Pragma("unroll") for (int k = 0; k < 2; ++k) \
        acc[ai][bj][m][n] = __builtin_amdgcn_mfma_f32_16x16x32_bf16(Bt[n][k], At[m][k], acc[ai][bj][m][n], 0, 0, 0); __builtin_amdgcn_s_setprio(0); } while (0)
#define PG8_WAIT_V(n) asm volatile("s_waitcnt vmcnt(" #n ")" ::: "memory")
#define PG8_WAIT_L(n) asm volatile("s_waitcnt lgkmcnt(" #n ")" ::: "memory")
#define PG8_BAR __builtin_amdgcn_s_barrier()
#define PG8_SCHED __builtin_amdgcn_sched_barrier(0)
    Unit cur, nxt; int ui = 0;
    if (!S.next(0, cur)) return;
    f32x4 acc[2][2][4][2];
#pragma unroll
    for (int a = 0; a < 2; ++a)
#pragma unroll
        for (int b = 0; b < 2; ++b)
#pragma unroll
            for (int m = 0; m < 4; ++m)
#pragma unroll
                for (int n = 0; n < 2; ++n) acc[a][b][m][n] = (f32x4){0.f, 0.f, 0.f, 0.f};
    bf16x8 At[4][2], B0[2][2], B1[2][2];
    const char* cA = (const char*)g.A + (size_t)cur.pm * tstep; const char* cB = (const char*)g.Bt + (size_t)cur.pn * tstep;
    S.a_ready(cur);
    if constexpr (SP2) {
        PG8_STAGE(PG8_SB(0, 0), cB, voffB); PG8_STAGE(PG8_SB(0, 1), cB + hstep, voffB); PG8_STAGE(PG8_SA(0, 0), cA, voffA); PG8_STAGE(PG8_SA(0, 1), cA + hstep, voffA);
        if (wr == 1) PG8_BAR;
        PG8_WAIT_V(2); PG8_BAR;
        PG8_STAGE(PG8_SB(1, 0), cB + kstep, voffB); PG8_STAGE(PG8_SA(1, 0), cA + kstep, voffA); PG8_STAGE(PG8_SB(1, 1), cB + hstep + kstep, voffB);
        PG8_WAIT_V(6); PG8_BAR;
    } else {
        PG8_STAGE(PG8_SB(0, 0), cB, voffB); PG8_STAGE(PG8_SA(0, 0), cA, voffA); PG8_STAGE(PG8_SB(0, 1), cB + hstep, voffB); PG8_STAGE(PG8_SA(0, 1), cA + hstep, voffA);
        if (wr == 1) PG8_BAR;
        PG8_WAIT_V(4); PG8_BAR;
        PG8_STAGE(PG8_SB(1, 0), cB + kstep, voffB); PG8_STAGE(PG8_SA(1, 0), cA + kstep, voffA); PG8_STAGE(PG8_SB(1, 1), cB + hstep + kstep, voffB);
        PG8_WAIT_V(6); PG8_BAR;
    }
    for (;;) {
        const bool has_next = S.next(ui + 1, nxt);
        const char* nA = has_next ? (const char*)g.A + (size_t)nxt.pm * tstep : cA; const char* nB = has_next ? (const char*)g.Bt + (size_t)nxt.pn * tstep : cB;
        for (int t = 0; t < nt; t += 2) {
            const bool last = (t == nt - 2);
            const char* a1 = cA + (size_t)(t + 1) * kstep;
            const char* a2 = last ? nA : cA + (size_t)(t + 2) * kstep; const char* b2 = last ? nB : cB + (size_t)(t + 2) * kstep;
            const char* a3 = a2 + kstep; const char* b3 = b2 + kstep;
            if (last && has_next) S.a_ready(nxt);
            if constexpr (SP2) {
            PG8_LDB(B0, 0, 0); PG8_LDB(B1, 0, 1); PG8_SCHED; PG8_LDA(At, 0, 0); PG8_STAGE(PG8_SA(1, 1), a1 + hstep, voffA);
            PG8_WAIT_V(8); PG8_WAIT_L(0); PG8_BAR; PG8_MMA(0, 0, At, B0); PG8_MMA(0, 1, At, B1); PG8_BAR; PG8_SCHED;
            PG8_LDA(At, 0, 1); PG8_STAGE(PG8_SB(0, 0), b2, voffB); PG8_STAGE(PG8_SB(0, 1), b2 + hstep, voffB); PG8_STAGE(PG8_SA(0, 0), a2, voffA);
            PG8_WAIT_V(8); PG8_WAIT_L(0); PG8_BAR; PG8_MMA(1, 0, At, B0); PG8_MMA(1, 1, At, B1); PG8_BAR; PG8_SCHED;
            PG8_LDB(B0, 1, 0); PG8_LDB(B1, 1, 1); PG8_SCHED; PG8_LDA(At, 1, 0); PG8_STAGE(PG8_SA(0, 1), a2 + hstep, voffA);
            PG8_WAIT_V(8); PG8_WAIT_L(0); PG8_BAR; PG8_MMA(0, 0, At, B0); PG8_MMA(0, 1, At, B1); PG8_BAR; PG8_SCHED;
            PG8_LDA(At, 1, 1); PG8_STAGE(PG8_SB(1, 0), b3, voffB); PG8_STAGE(PG8_SB(1, 1), b3 + hstep, voffB); PG8_STAGE(PG8_SA(1, 0), a3, voffA);
            PG8_WAIT_V(8); PG8_WAIT_L(0); PG8_BAR; PG8_MMA(1, 0, At, B0); PG8_MMA(1, 1, At, B1); PG8_BAR; PG8_SCHED;
            } else {
            PG8_LDB(B0, 0, 0); PG8_SCHED; PG8_LDA(At, 0, 0); PG8_STAGE(PG8_SA(1, 1), a1 + hstep, voffA);
            PG8_WAIT_L(8); PG8_BAR; PG8_WAIT_L(0); PG8_MMA(0, 0, At, B0); PG8_BAR; PG8_SCHED;
            PG8_LDB(B1, 0, 1); PG8_STAGE(PG8_SB(0, 0), b2, voffB);
            PG8_BAR; PG8_WAIT_L(0); PG8_MMA(0, 1, At, B1); PG8_BAR;
            PG8_LDA(At, 0, 1); PG8_STAGE(PG8_SA(0, 0), a2, voffA);
            PG8_BAR; PG8_WAIT_L(0); PG8_MMA(1, 0, At, B0); PG8_BAR; PG8_SCHED;
            PG8_STAGE(PG8_SB(0, 1), b2 + hstep, voffB);
            PG8_WAIT_V(6); PG8_BAR; PG8_MMA(1, 1, At, B1); PG8_BAR;
            PG8_LDB(B0, 1, 0); PG8_SCHED; PG8_LDA(At, 1, 0); PG8_STAGE(PG8_SA(0, 1), a2 + hstep, voffA);
            PG8_WAIT_L(8); PG8_BAR; PG8_WAIT_L(0); PG8_MMA(0, 0, At, B0); PG8_BAR; PG8_SCHED;
            PG8_LDB(B1, 1, 1); PG8_STAGE(PG8_SB(1, 0), b3, voffB);
            PG8_BAR; PG8_WAIT_L(0); PG8_MMA(0, 1, At, B1); PG8_BAR;
            PG8_LDA(At, 1, 1); PG8_STAGE(PG8_SA(1, 0), a3, voffA);
            PG8_BAR; PG8_WAIT_L(0); PG8_MMA(1, 0, At, B0); PG8_BAR; PG8_SCHED;
            PG8_STAGE(PG8_SB(1, 1), b3 + hstep, voffB);
            PG8_WAIT_V(6); PG8_BAR; PG8_MMA(1, 1, At, B1); PG8_BAR;
            }
        }
        if constexpr (ALIGN_EPI) { if (wr == 0) PG8_BAR; }
        if constexpr (!Epi::AFTER_DRAIN) { E(acc, cur, wr, wc, fr, fq); S.done(cur); }
        if (!has_next) break;
#pragma unroll
        for (int a = 0; a < 2; ++a)
#pragma unroll
            for (int b = 0; b < 2; ++b)
#pragma unroll
                for (int m = 0; m < 4; ++m)
#pragma unroll
                    for (int n = 0; n < 2; ++n) acc[a][b][m][n] = (f32x4){0.f, 0.f, 0.f, 0.f};
        cur = nxt; cA = nA; cB = nB; ++ui;
        if constexpr (ALIGN_EPI) { if (wr == 1) PG8_BAR; }
    }
    PG8_WAIT_V(0);
    if constexpr (!ALIGN_EPI) { if (wr == 0) PG8_BAR; }
    PG8_BAR;
    if constexpr (Epi::AFTER_DRAIN) { E.fused(acc, cur, wr, wc, fr, fq, lds, wid, lane); S.done(cur); }
#undef PG8_SA
#undef PG8_SB
#undef PG8_STAGE
#undef PG8_LDA
#undef PG8_LDB
#undef PG8_MMA
#undef PG8_WAIT_V
#undef PG8_WAIT_L
#undef PG8_BAR
#undef PG8_SCHED
}
}
typedef pg8::bf16_t bf16_t;
typedef pg8::bf16x8 bf16x8;
typedef pg8::f32x4 f32x4;
typedef pg8::u32x4 u32x4;
typedef unsigned u32x2 __attribute__((ext_vector_type(2)));
#define LAS __attribute__((address_space(3)))
constexpr int MTOK = 32768, DM = 1024, SEQ = 2048, NPROJ = 3584, DFF = 4096, PLED = 256, LDWIN = 3592;
constexpr int C_GQ = 0, C_GK = 512, C_GV = 1024, C_GZ = 1536, C_MQ = 2048, C_MK = 2560, C_MV = 3072;
constexpr float RMS_EPS = 1e-6f;
constexpr int LDS_BYTES = 143360;
constexpr size_t WS_KMAX = 0;
constexpr size_t WS_WIN = 4096, WS_WOUT = WS_WIN + (size_t)NPROJ * DM * 2, WS_WUP = WS_WOUT + (size_t)DM * DM * 2, WS_WDOWN = WS_WUP + (size_t)DFF * DM * 2,
    WS_WGATE = WS_WDOWN + (size_t)DFF * DM * 2, WS_WPLE = WS_WGATE + (size_t)DM * DM * 2, WS_ROPE = WS_WPLE + (size_t)DM * PLED * 2, WS_LG = WS_ROPE + (size_t)SEQ * 32 * 4,
    WS_KMEAN = WS_LG + (size_t)MTOK * 8 * 4, WS_PB = WS_KMEAN + (size_t)64 * 8 * 128 * 4, WS_U = WS_PB + (size_t)MTOK * PLED * 2, WS_VT = WS_U + (size_t)MTOK * DM * 2,
    WS_MIXIN = WS_VT + (size_t)64 * 128 * SEQ * 2, WS_BIG = WS_MIXIN + (size_t)MTOK * DM * 2, WS_END = WS_BIG + (size_t)MTOK * DFF * 2;
constexpr size_t WS_RS0 = WS_END + 8192 + (size_t)2048 * 16384 + 256 + 16384, WS_RS2 = WS_RS0 + (size_t)MTOK * 4, WS_TOTAL = WS_RS2 + (size_t)MTOK * 4;

struct Params {
    const float *x, *p, *w_in, *conv_w, *a_log, *dt_bias, *gdn_norm_w, *w_out, *n_pre_attn, *n_post_attn, *n_pre_mlp, *n_post_mlp, *w_up, *w_down, *w_ple, *w_gate;
    float* out; unsigned char* ws;
    float inv_freq[16];
    int coop_marker, pad;
};

__device__ __forceinline__ float wave_sum(float v) {
#pragma unroll
    for (int o = 1; o < 64; o <<= 1) v += __shfl_xor(v, o);
    return v;
}
#define DPP_F_(v_, ctrl_) __builtin_bit_cast(float, __builtin_amdgcn_update_dpp(0, __builtin_bit_cast(int, (v_)), (ctrl_), 0xf, 0xf, false))
__device__ __forceinline__ float row16_sum(float v) { v += DPP_F_(v, 0x128); v += DPP_F_(v, 0x124); v += DPP_F_(v, 0x122); v += DPP_F_(v, 0x121); return v; }
__device__ __forceinline__ float half8_sum(float v) { v += DPP_F_(v, 0xB1); v += DPP_F_(v, 0x4E); v += DPP_F_(v, 0x141); return v; }
#define ROWLOOP3(BUFT, LOADF, PROC) do { BUFT A_, B_, C_; int m = gw; LOADF(A_, m); LOADF(B_, min(m + NGW, MTOK - 1)); \
    for (;; m += 3 * NGW) { \
        LOADF(C_, min(m + 2 * NGW, MTOK - 1)); \
        PROC(A_, m); if (m + NGW >= MTOK) break; \
        LOADF(A_, min(m + 3 * NGW, MTOK - 1)); \
        PROC(B_, m + NGW); if (m + 2 * NGW >= MTOK) break; \
        LOADF(B_, min(m + 4 * NGW, MTOK - 1)); \
        PROC(C_, m + 2 * NGW); if (m + 3 * NGW >= MTOK) break; } } while (0)
__device__ __forceinline__ float bflo(unsigned w) { return __uint_as_float(w << 16); }
__device__ __forceinline__ float bfhi(unsigned w) { return __uint_as_float(w & 0xffff0000u); }
__device__ __forceinline__ unsigned pk2(float lo, float hi) { return pg8::cvt_pk_bf16(lo, hi); }
__device__ __forceinline__ float silu_f(float v) { return v * __builtin_amdgcn_rcpf(1.f + __expf(-v)); }

__device__ __forceinline__ void transpose_item(const float* W, int ldw, int K, int k0, int srccol0, bf16_t* WT, int n0, float* scr, int lane, const float* kscale) {
    f32x4 ldv[8];
#pragma unroll
    for (int i = 0; i < 8; ++i) ldv[i] = *(const f32x4*)(W + (size_t)(k0 + 8 * i + (lane >> 3)) * ldw + srccol0 + 4 * (lane & 7));
#pragma unroll
    for (int i = 0; i < 8; ++i) { float* d = scr + (8 * i + (lane >> 3)) * 33 + 4 * (lane & 7); const float sc = kscale ? kscale[k0 + 8 * i + (lane >> 3)] : 1.f;
        d[0] = ldv[i][0] * sc; d[1] = ldv[i][1] * sc; d[2] = ldv[i][2] * sc; d[3] = ldv[i][3] * sc; }
    __builtin_amdgcn_s_waitcnt(0xc07f); asm volatile("s_waitcnt lgkmcnt(0)" ::: "memory");
    const int c = lane & 7;
#pragma unroll
    for (int j = 0; j < 4; ++j) { const int n = (lane >> 3) + 8 * j; const float* s = scr + (8 * c) * 33 + n;
        u32x4 o; o.x = pk2(s[0 * 33], s[1 * 33]); o.y = pk2(s[2 * 33], s[3 * 33]); o.z = pk2(s[4 * 33], s[5 * 33]); o.w = pk2(s[6 * 33], s[7 * 33]);
        *(u32x4*)(WT + (size_t)(n0 + n) * K + k0 + 8 * c) = o; }
    asm volatile("s_waitcnt lgkmcnt(0)" ::: "memory");
}
__device__ __forceinline__ void transpose_matrix(const float* W, int ldw, int K, int N, bool is_win, bf16_t* WT, float* scr, int gw, int NGW, int lane, const float* kscale = nullptr) {
    const int nblk = N / 32, items = (K / 64) * nblk;
    for (int it = gw; it < items; it += NGW) { const int kb = it / nblk, nb = it % nblk; const int n0 = nb * 32; const int src = is_win ? (n0 >= 2048 ? n0 + 8 : n0) : n0;
        transpose_item(W, ldw, K, kb * 64, src, WT, n0, scr, lane, kscale); }
}
__device__ __forceinline__ void phase0(const Params& P, unsigned char* smem) {
    int tid_ = threadIdx.x; asm volatile("" : "+v"(tid_)); const int tid = tid_, lane = tid & 63, wave = __builtin_amdgcn_readfirstlane(tid >> 6); const int G = gridDim.x; const int gw = blockIdx.x * 8 + wave, NGW = G * 8;
    unsigned char* ws = P.ws;
    float* scr = (float*)(smem + 32768) + wave * (64 * 33);
    transpose_matrix(P.w_in, LDWIN, DM, NPROJ, true, (bf16_t*)(ws + WS_WIN), scr, gw, NGW, lane, P.n_pre_attn);
    transpose_matrix(P.w_out, DM, DM, DM, false, (bf16_t*)(ws + WS_WOUT), scr, gw, NGW, lane);
    transpose_matrix(P.w_up, DFF, DM, DFF, false, (bf16_t*)(ws + WS_WUP), scr, gw, NGW, lane, P.n_pre_mlp);
    transpose_matrix(P.w_down, DM, DFF, DM, false, (bf16_t*)(ws + WS_WDOWN), scr, gw, NGW, lane);
    transpose_matrix(P.w_gate, DM, DM, DM, false, (bf16_t*)(ws + WS_WGATE), scr, gw, NGW, lane);
    transpose_matrix(P.w_ple, DM, PLED, DM, false, (bf16_t*)(ws + WS_WPLE), scr, gw, NGW, lane);
    { float* rope = (float*)(ws + WS_ROPE);
      for (int i = blockIdx.x * 512 + tid; i < SEQ * 16; i += G * 512) { const int t = i >> 4, d = i & 15; const float ang = (float)t * P.inv_freq[d];
          double rev = (double)ang * 0.15915494309189533577; rev -= __builtin_rint(rev); const float fr = (float)rev;
          rope[t * 32 + d] = __builtin_amdgcn_cosf(fr); rope[t * 32 + 16 + d] = __builtin_amdgcn_sinf(fr); } }
    { bf16_t* pb = (bf16_t*)(ws + WS_PB); const size_t n8 = (size_t)MTOK * PLED / 8;
      for (size_t i = (size_t)blockIdx.x * 512 + tid; i < n8; i += (size_t)G * 512) { const f32x4 a = *(const f32x4*)(P.p + i * 8), b = *(const f32x4*)(P.p + i * 8 + 4);
          u32x4 o; o.x = pk2(a[0], a[1]); o.y = pk2(a[2], a[3]); o.z = pk2(b[0], b[1]); o.w = pk2(b[2], b[3]); *(u32x4*)(pb + i * 8) = o; } }
    __syncthreads();
    { bf16_t* U = (bf16_t*)(ws + WS_U); float* LG = (float*)(ws + WS_LG);
      f32x4 wn[4];
#pragma unroll
      for (int j = 0; j < 4; ++j) wn[j] = *((const f32x4*)P.n_pre_attn + lane + 64 * j);
      f32x4 wl0[4][4], wl1[4][4];
#pragma unroll
      for (int j = 0; j < 4; ++j)
#pragma unroll
          for (int e = 0; e < 4; ++e) { const float* wp = P.w_in + (size_t)(4 * lane + 256 * j + e) * LDWIN + 2048; wl0[j][e] = *(const f32x4*)wp; wl1[j][e] = *(const f32x4*)(wp + 4); }
#define PN_LOAD(buf, mm) do { _Pragma("unroll") for (int j_ = 0; j_ < 4; ++j_) buf.c[j_] = *((const f32x4*)(P.x + (size_t)(mm) * DM) + lane + 64 * j_); } while (0)
#define PN_PROC(buf, mm) do { const int m_ = (mm); f32x4 v[4]; float s_ = 0.f; \
          _Pragma("unroll") for (int j = 0; j < 4; ++j) { v[j] = buf.c[j]; s_ += (v[j][0] * v[j][0] + v[j][1] * v[j][1]) + (v[j][2] * v[j][2] + v[j][3] * v[j][3]); } \
          const float rstd = rsqrtf(wave_sum(s_) * (1.f / DM) + RMS_EPS); \
          float lg[8]; _Pragma("unroll") for (int c = 0; c < 8; ++c) lg[c] = 0.f; \
          if (lane == 0) ((float*)(ws + WS_RS0))[m_] = rstd; \
          _Pragma("unroll") for (int j = 0; j < 4; ++j) { \
              u32x2 o; o.x = pk2(v[j][0], v[j][1]); o.y = pk2(v[j][2], v[j][3]); *(u32x2*)(U + (size_t)m_ * DM + 4 * lane + 256 * j) = o; v[j] = v[j] * rstd * wn[j]; \
              _Pragma("unroll") for (int e = 0; e < 4; ++e) { _Pragma("unroll") for (int c = 0; c < 4; ++c) { lg[c] += v[j][e] * wl0[j][e][c]; lg[4 + c] += v[j][e] * wl1[j][e][c]; } } } \
            \
          { const bool b0 = (lane & 1) != 0, b1 = (lane & 2) != 0, b2 = (lane & 4) != 0; float h4[4], h2[2], h1; \
            _Pragma("unroll") for (int i = 0; i < 4; ++i) { const float send = b0 ? lg[i] : lg[i + 4], keep = b0 ? lg[i + 4] : lg[i]; h4[i] = keep + __shfl_xor(send, 1); } \
            _Pragma("unroll") for (int i = 0; i < 2; ++i) { const float send = b1 ? h4[i] : h4[i + 2], keep = b1 ? h4[i + 2] : h4[i]; h2[i] = keep + __shfl_xor(send, 2); } \
            { const float send = b2 ? h2[0] : h2[1], keep = b2 ? h2[1] : h2[0]; h1 = keep + __shfl_xor(send, 4); } \
            h1 += __shfl_xor(h1, 8); h1 += __shfl_xor(h1, 16); h1 += __shfl_xor(h1, 32); \
            if (lane < 8) LG[(size_t)m_ * 8 + 4 * (lane & 1) + 2 * ((lane >> 1) & 1) + ((lane >> 2) & 1)] = h1; } } while (0)
      struct XBuf { f32x4 c[4]; };
      ROWLOOP3(XBuf, PN_LOAD, PN_PROC);
#undef PN_LOAD
#undef PN_PROC
    }
}

__device__ __forceinline__ void moba_prep(const Params& P, unsigned char* smem) {
    int tid_ = threadIdx.x; asm volatile("" : "+v"(tid_)); const int tid = tid_; unsigned char* ws = P.ws;
    bf16_t* PROJ = (bf16_t*)(ws + WS_BIG); const float* rope = (const float*)(ws + WS_ROPE); float* KMEAN = (float*)(ws + WS_KMEAN); bf16_t* VT = (bf16_t*)(ws + WS_VT);
    unsigned char* vt = smem;
    float* red = (float*)(smem + 69632);
    const int p = tid & 15, r = tid >> 4;
    for (int unit = blockIdx.x; unit < 512; unit += gridDim.x) {
        const int bh = unit >> 3, n = unit & 7, b = bh >> 2, h = bh & 3; const int m0 = b * SEQ + n * 256;
        float ksum[8]; float kmax2 = 0.f;
#pragma unroll
        for (int e = 0; e < 8; ++e) ksum[e] = 0.f;
        u32x4 lq[8], lk[8], lv[8];
#pragma unroll
        for (int i = 0; i < 8; ++i) { const size_t m = (size_t)(m0 + r + 32 * i); const bf16_t* bp = PROJ + m * NPROJ + h * 128 + 8 * p;
            lq[i] = *(const u32x4*)(bp + C_MQ); lk[i] = *(const u32x4*)(bp + C_MK); lv[i] = *(const u32x4*)(bp + C_MV); }
#pragma unroll
        for (int i = 0; i < 8; ++i) { const int row = r + 32 * i, t = n * 256 + row; const size_t m = (size_t)(m0 + row);
#pragma unroll
            for (int ten = 0; ten < 2; ++ten) {
                bf16_t* ptr = PROJ + m * NPROJ + (ten == 0 ? C_MQ : C_MK) + h * 128 + 8 * p;
                const u32x4 w = (ten == 0) ? lq[i] : lk[i]; u32x4 o; o.x = __shfl_xor(w.x, 2); o.y = __shfl_xor(w.y, 2); o.z = __shfl_xor(w.z, 2); o.w = __shfl_xor(w.w, 2);
                float a[8] = {bflo(w.x), bfhi(w.x), bflo(w.y), bfhi(w.y), bflo(w.z), bfhi(w.z), bflo(w.w), bfhi(w.w)};
                if (p < 4) {
                    const float bb[8] = {bflo(o.x), bfhi(o.x), bflo(o.y), bfhi(o.y), bflo(o.z), bfhi(o.z), bflo(o.w), bfhi(o.w)};
                    const float* cs = rope + t * 32 + 8 * (p & 1);
                    const f32x4 c0 = *(const f32x4*)cs, c1 = *(const f32x4*)(cs + 4), s0 = *(const f32x4*)(cs + 16), s1 = *(const f32x4*)(cs + 20);
                    const float cc[8] = {c0[0], c0[1], c0[2], c0[3], c1[0], c1[1], c1[2], c1[3]}, ss[8] = {s0[0], s0[1], s0[2], s0[3], s1[0], s1[1], s1[2], s1[3]};
#pragma unroll
                    for (int e = 0; e < 8; ++e) a[e] = (p < 2) ? (a[e] * cc[e] - bb[e] * ss[e]) : (a[e] * cc[e] + bb[e] * ss[e]);
                    u32x4 st; st.x = pk2(a[0], a[1]); st.y = pk2(a[2], a[3]); st.z = pk2(a[4], a[5]); st.w = pk2(a[6], a[7]);
                    *(u32x4*)ptr = st;
                }
                if (ten == 1) { float kn = 0.f;
#pragma unroll
                    for (int e = 0; e < 8; ++e) { ksum[e] += a[e]; const float ab = bflo(pk2(a[e], 0.f)); kn += ab * ab; }
                    kn = row16_sum(kn); kmax2 = fmaxf(kmax2, kn);
                }
            }
            *(u32x4*)(vt + row * 272 + 16 * p) = lv[i];
        }
#pragma unroll
        for (int e = 0; e < 8; ++e) red[r * 128 + 8 * p + e] = ksum[e];
        if (p == 0) red[4096 + r] = kmax2;
        __syncthreads();
        if (tid < 128) { float s = 0.f; for (int q = 0; q < 32; ++q) s += red[q * 128 + tid]; KMEAN[((size_t)bh * 8 + n) * 128 + tid] = s * (1.f / 256.f); }
        if (tid == 128) { float mx = 0.f; for (int q = 0; q < 32; ++q) mx = fmaxf(mx, red[4096 + q]); ((float*)(ws + WS_KMAX))[bh * 8 + n] = sqrtf(mx); }
        { const int d = tid & 127, tg = tid >> 7;
          for (int gi = 0; gi < 8; ++gi) { const int g = tg * 8 + gi, s32 = g >> 2, fq = g & 3; unsigned short e8[8];
#pragma unroll
              for (int j = 0; j < 8; ++j) { const int tok = 32 * s32 + (j < 4 ? 4 * fq + j : 16 + 4 * fq + (j - 4)); e8[j] = *(const unsigned short*)(vt + tok * 272 + 2 * d); }
              u32x4 o; o.x = e8[0] | ((unsigned)e8[1] << 16); o.y = e8[2] | ((unsigned)e8[3] << 16); o.z = e8[4] | ((unsigned)e8[5] << 16); o.w = e8[6] | ((unsigned)e8[7] << 16);
              *(u32x4*)(VT + ((size_t)bh * 128 + d) * SEQ + n * 256 + 8 * g) = o; } }
        __syncthreads();
    }
}

__device__ __forceinline__ void moba_unit(const Params& P, unsigned char* smem, int bh, int qb) {
    int tid_ = threadIdx.x; asm volatile("" : "+v"(tid_)); const int tid = tid_, lane = tid & 63, w = tid >> 6, fr = lane & 15, fq = lane >> 4; const int b = bh >> 2, h = bh & 3;
    unsigned char* ws = P.ws;
    const bf16_t* PROJ = (const bf16_t*)(ws + WS_BIG); const float* KMEAN = (const float*)(ws + WS_KMEAN); const bf16_t* VT = (const bf16_t*)(ws + WS_VT); bf16_t* MIXIN = (bf16_t*)(ws + WS_MIXIN);
    const int qrow0 = qb * 256 + 32 * w;
    bf16x8 qf[2][4];
#pragma unroll
    for (int rt = 0; rt < 2; ++rt)
#pragma unroll
        for (int ks = 0; ks < 4; ++ks) qf[rt][ks] = *(const bf16x8*)(PROJ + (size_t)(b * SEQ + qrow0 + 16 * rt + fr) * NPROJ + C_MQ + h * 128 + 32 * ks + 8 * fq);
    unsigned selmask[2];
    if (qb <= 3) { selmask[0] = selmask[1] = (1u << qb) - 1u; }
    else {
        bf16x8 kmf[4];
#pragma unroll
        for (int ks = 0; ks < 4; ++ks) { const float* src = KMEAN + ((size_t)bh * 8 + (fr & 7)) * 128 + 32 * ks + 8 * fq; const f32x4 a = *(const f32x4*)src, c = *(const f32x4*)(src + 4);
            u32x4 o; o.x = pk2(a[0], a[1]); o.y = pk2(a[2], a[3]); o.z = pk2(c[0], c[1]); o.w = pk2(c[2], c[3]); if (fr >= 8) o = (u32x4){0u, 0u, 0u, 0u};
            kmf[ks] = __builtin_bit_cast(bf16x8, o); }
#pragma unroll
        for (int rt = 0; rt < 2; ++rt) { f32x4 g = {0.f, 0.f, 0.f, 0.f};
#pragma unroll
            for (int ks = 0; ks < 4; ++ks) g = __builtin_amdgcn_mfma_f32_16x16x32_bf16(kmf[ks], qf[rt][ks], g, 0, 0, 0);
            float gv[8];
#pragma unroll
            for (int i = 0; i < 4; ++i) { gv[i] = __shfl(g[i], fr); gv[4 + i] = __shfl(g[i], 16 + fr); }
            unsigned msk = 0u;
#pragma unroll
            for (int rep = 0; rep < 3; ++rep) { float best = -INFINITY; int bi = 0;
#pragma unroll
                for (int n = 0; n < 8; ++n) { const bool ok = (n < qb) && !((msk >> n) & 1u) && (gv[n] > best); best = ok ? gv[n] : best; bi = ok ? n : bi; }
                msk |= 1u << bi; }
            selmask[rt] = msk; }
    }
    float bound[2];
    { float kmx = 0.f; const float* KM = (const float*)(ws + WS_KMAX) + bh * 8;
      { const f32x4 k0 = *(const f32x4*)KM, k1 = *(const f32x4*)(KM + 4); const float kv[8] = {k0[0], k0[1], k0[2], k0[3], k1[0], k1[1], k1[2], k1[3]};
#pragma unroll
        for (int n = 0; n < 8; ++n) kmx = (n <= qb) ? fmaxf(kmx, kv[n]) : kmx; }
#pragma unroll
      for (int rt = 0; rt < 2; ++rt) { float q2 = 0.f;
#pragma unroll
          for (int ks = 0; ks < 4; ++ks)
#pragma unroll
              for (int e = 0; e < 8; ++e) { const float qv = __uint_as_float((unsigned)(unsigned short)qf[rt][ks][e] << 16); q2 += qv * qv; }
          q2 += __shfl_xor(q2, 16); q2 += __shfl_xor(q2, 32);
          bound[rt] = fminf(sqrtf(q2) * kmx * (0.08838834764831845f * 1.4426950408889634f) * 1.0001f, 96.f); } }
    f32x4 O[2][8]; float lsum[2];
#pragma unroll
    for (int rt = 0; rt < 2; ++rt) { lsum[rt] = 0.f;
#pragma unroll
        for (int dt = 0; dt < 8; ++dt) O[rt][dt] = (f32x4){0.f, 0.f, 0.f, 0.f}; }
    const int ntiles = (qb + 1) * 4;
    const int krow0 = tid >> 4, kpc = tid & 15;
    const int vrow0 = tid >> 3, vpc = tid & 7;
    const bf16_t* kbase = PROJ + (size_t)(b * SEQ) * NPROJ + C_MK + h * 128 + 8 * kpc;
    const bf16_t* vbase = VT + (size_t)bh * 128 * SEQ + 8 * vpc;
    u32x4 st[4];
#define MOBA_LOAD(key0) do { st[0] = *(const u32x4*)(kbase + (size_t)((key0) + krow0) * NPROJ); st[1] = *(const u32x4*)(kbase + (size_t)((key0) + krow0 + 32) * NPROJ); \
        st[2] = *(const u32x4*)(vbase + (size_t)vrow0 * SEQ + (key0)); st[3] = *(const u32x4*)(vbase + (size_t)(vrow0 + 64) * SEQ + (key0)); } while (0)
#define MOBA_STORE(buf) do { unsigned char* kb_ = smem + (buf) * 35840; unsigned char* vb_ = kb_ + 17408; \
        *(u32x4*)(kb_ + krow0 * 272 + kpc * 16) = st[0]; *(u32x4*)(kb_ + (krow0 + 32) * 272 + kpc * 16) = st[1]; \
        *(u32x4*)(vb_ + vrow0 * 144 + vpc * 16) = st[2]; *(u32x4*)(vb_ + (vrow0 + 64) * 144 + vpc * 16) = st[3]; } while (0)
    MOBA_LOAD(0); MOBA_STORE(0);
    __syncthreads();
    const float SC = 0.08838834764831845f * 1.4426950408889634f;
    for (int tt = 0; tt < ntiles; ++tt) {
        const int n = tt >> 2, key0 = tt * 64; const int buf = tt & 1;
        if (tt + 1 < ntiles) MOBA_LOAD(key0 + 64);
        const unsigned char* kb = smem + buf * 35840; const unsigned char* vb = kb + 17408;
        f32x4 s[2][4];
#pragma unroll
        for (int rt = 0; rt < 2; ++rt)
#pragma unroll
            for (int kt = 0; kt < 4; ++kt) s[rt][kt] = (f32x4){0.f, 0.f, 0.f, 0.f};
        bf16x8 ga[4], gb[4];
#define LDK_(F, kt_) do { _Pragma("unroll") for (int ks_ = 0; ks_ < 4; ++ks_) F[ks_] = *(const bf16x8*)(kb + (16 * (kt_) + fr) * 272 + (32 * ks_ + 8 * fq) * 2); } while (0)
#define MMS_(F, kt_) do { _Pragma("unroll") for (int ks_ = 0; ks_ < 4; ++ks_) { s[0][kt_] = __builtin_amdgcn_mfma_f32_16x16x32_bf16(F[ks_], qf[0][ks_], s[0][kt_], 0, 0, 0); s[1][kt_] = __builtin_amdgcn_mfma_f32_16x16x32_bf16(F[ks_], qf[1][ks_], s[1][kt_], 0, 0, 0); } } while (0)
#define LDV_(F, sl_, d0_) do { _Pragma("unroll") for (int dd_ = 0; dd_ < 4; ++dd_) F[dd_] = *(const bf16x8*)(vb + (16 * ((d0_) + dd_) + fr) * 144 + (32 * (sl_) + 8 * fq) * 2); } while (0)
#define MMV_(F, sl_, d0_) do { _Pragma("unroll") for (int dd_ = 0; dd_ < 4; ++dd_) { O[0][(d0_) + dd_] = __builtin_amdgcn_mfma_f32_16x16x32_bf16(F[dd_], pf[0][sl_], O[0][(d0_) + dd_], 0, 0, 0); O[1][(d0_) + dd_] = __builtin_amdgcn_mfma_f32_16x16x32_bf16(F[dd_], pf[1][sl_], O[1][(d0_) + dd_], 0, 0, 0); } } while (0)
#define SB0_() __builtin_amdgcn_sched_barrier(0)
        LDK_(ga, 0); LDK_(gb, 1); SB0_();
        MMS_(ga, 0); SB0_(); LDK_(ga, 2); SB0_();
        MMS_(gb, 1); SB0_(); LDK_(gb, 3); SB0_();
        MMS_(ga, 2); SB0_(); LDV_(ga, 0, 0); SB0_();
        MMS_(gb, 3); SB0_(); LDV_(gb, 0, 4); SB0_();
        bf16x8 pf[2][2];
#pragma unroll
        for (int rt = 0; rt < 2; ++rt) {
            const int row_t = qrow0 + 16 * rt + fr;
            const bool rowsel = (n < qb) ? (((selmask[rt] >> n) & 1u) != 0u) : true;
            if (n == qb) {
#pragma unroll
                for (int kt = 0; kt < 4; ++kt)
#pragma unroll
                    for (int i = 0; i < 4; ++i) { const int key = key0 + 16 * kt + 4 * fq + i; if (key > row_t) s[rt][kt][i] = -INFINITY; }
            }
            const float msub = rowsel ? -bound[rt] : -INFINITY;
            float ps = 0.f;
#pragma unroll
            for (int kt = 0; kt < 4; ++kt)
#pragma unroll
                for (int i = 0; i < 4; ++i) { const float pv = __builtin_amdgcn_exp2f(fmaf(s[rt][kt][i], SC, msub)); s[rt][kt][i] = pv; ps += pv; }
            lsum[rt] += ps;
#pragma unroll
            for (int sl = 0; sl < 2; ++sl) { u32x4 o; o.x = pk2(s[rt][2 * sl][0], s[rt][2 * sl][1]); o.y = pk2(s[rt][2 * sl][2], s[rt][2 * sl][3]);
                o.z = pk2(s[rt][2 * sl + 1][0], s[rt][2 * sl + 1][1]); o.w = pk2(s[rt][2 * sl + 1][2], s[rt][2 * sl + 1][3]); pf[rt][sl] = __builtin_bit_cast(bf16x8, o); }
        }
        SB0_(); MMV_(ga, 0, 0); SB0_(); LDV_(ga, 1, 0); SB0_();
        MMV_(gb, 0, 4); SB0_(); LDV_(gb, 1, 4); SB0_();
        MMV_(ga, 1, 0); SB0_(); MMV_(gb, 1, 4); SB0_();
#undef LDK_
#undef MMS_
#undef LDV_
#undef MMV_
#undef SB0_
        if (tt + 1 < ntiles) MOBA_STORE(buf ^ 1);
        __syncthreads();
    }
#undef MOBA_LOAD
#undef MOBA_STORE
#pragma unroll
    for (int rt = 0; rt < 2; ++rt) { float l = lsum[rt]; l += __shfl_xor(l, 16); l += __shfl_xor(l, 32); const float inv = 1.f / l;
        bf16_t* orow = MIXIN + (size_t)(b * SEQ + qrow0 + 16 * rt + fr) * DM + 512 + h * 128 + 4 * fq;
#pragma unroll
        for (int dt = 0; dt < 8; ++dt) { u32x2 o; o.x = pk2(O[rt][dt][0] * inv, O[rt][dt][1] * inv); o.y = pk2(O[rt][dt][2] * inv, O[rt][dt][3] * inv); *(u32x2*)(orow + 16 * dt) = o; } }
}

constexpr size_t WS_LBUF = WS_U, WS_GLAST = WS_END, WS_BVT = WS_END + 8192;
constexpr size_t WS_END2 = WS_BVT + (size_t)2048 * 16384;
__device__ __forceinline__ unsigned bf1(float v) { return pk2(v, 0.f) & 0xffffu; }

__host__ __device__ constexpr int ltri_off(int i) { return i <= 0 ? 0 : (((i - 1) >> 2) + 1) * (2 * ((i - 1) >> 2) + ((i - 1) & 3)); }
__device__ __forceinline__ void gdn_prep(const Params& P, unsigned char* smem) {
    int tid_ = threadIdx.x; asm volatile("" : "+v"(tid_)); const int tid = tid_, lane = tid & 63, wave = tid >> 6, fr = lane & 15, fq = lane >> 4; unsigned char* ws = P.ws;
    const bf16_t* PROJ = (const bf16_t*)(ws + WS_BIG); const float* LG = (const float*)(ws + WS_LG); unsigned char* REC = (unsigned char*)P.out;
    bf16_t* BVT = (bf16_t*)(ws + WS_BVT); float* GLAST = (float*)(ws + WS_GLAST);
    unsigned char* Kb = smem; unsigned char* Qb = smem + 17408; unsigned char* Vb = smem + 34816;
    float* gsA = (float*)(smem + 52224); float* bsA = gsA + 512; float* esA = bsA + 512; float* egA = esA + 512;
    float* cwl = (float*)(smem + 60416);
    unsigned char* Lp = smem + 66560;
    const int p = tid & 15, rg = tid >> 4; const int G = gridDim.x; int hcur = -1;
    for (int k0 = 0; (int)blockIdx.x + k0 * G < 2048; k0 += 8) {
        { const int chunk = blockIdx.x + (k0 + wave) * G;
          if (chunk < 2048) { const int bh = chunk >> 5, n = chunk & 31, b = bh >> 2, h = bh & 3; const size_t m = (size_t)(b * SEQ + n * 64 + lane);
            const float gb = LG[m * 8 + h], ga = LG[m * 8 + 4 + h] + P.dt_bias[h];
            const float beta = 1.f / (1.f + __expf(-gb)); const float sp = ga > 20.f ? ga : log1pf(__expf(ga)); float g = -__expf(P.a_log[h]) * sp;
#pragma unroll
            for (int o = 1; o < 64; o <<= 1) { const float v = __shfl_up(g, o); if (lane >= o) g += v; }
            const float g63 = __shfl(g, 63);
            gsA[wave * 64 + lane] = g; bsA[wave * 64 + lane] = beta; esA[wave * 64 + lane] = __expf(g63 - g); egA[wave * 64 + lane] = __expf(g);
            if (lane == 63) GLAST[chunk] = __expf(g); } }
        __syncthreads();
        u32x4 ld[2][5];
        for (int ci = 0; ci < 8; ++ci) {
            const int chunk = blockIdx.x + (k0 + ci) * G; if (chunk >= 2048) break;
            const int bh = chunk >> 5, n = chunk & 31, b = bh >> 2, h = bh & 3, t0 = n * 64;
            unsigned char* rec = REC + (size_t)chunk * 65536;
            const float* gs = gsA + ci * 64; const float* bs = bsA + ci * 64; const float* es = esA + ci * 64; const float* eg = egA + ci * 64;
            if (h != hcur) { __syncthreads(); for (int i = tid; i < 1536; i += 512) { const int ten = i >> 9, tap = (i >> 7) & 3, c = i & 127; cwl[i] = P.conv_w[tap * 1536 + ten * 512 + h * 128 + c]; } hcur = h; __syncthreads(); }
#define CONV_LOAD(buf, ten_) do { _Pragma("unroll") for (int i_ = 0; i_ < 5; ++i_) { const int tt_ = t0 + 2 * rg - 3 + i_; \
                    ld[buf][i_] = *(const u32x4*)(PROJ + (size_t)(b * SEQ + max(tt_, 0)) * NPROJ + (ten_) * 512 + h * 128 + 8 * p); } } while (0)
            if (ci == 0) CONV_LOAD(0, 0);
#pragma unroll
            for (int ten = 0; ten < 3; ++ten) { float a0[8], a1[8];
                if (ten < 2) CONV_LOAD((ten + 1) & 1, ten + 1);
#pragma unroll
                for (int e = 0; e < 8; ++e) { a0[e] = 0.f; a1[e] = 0.f; }
#pragma unroll
                for (int i = 0; i < 5; ++i) { u32x4 w = ld[ten & 1][i]; if (t0 + 2 * rg - 3 + i < 0) w = (u32x4){0u, 0u, 0u, 0u}; const float xv[8] = {bflo(w.x), bfhi(w.x), bflo(w.y), bfhi(w.y), bflo(w.z), bfhi(w.z), bflo(w.w), bfhi(w.w)};
                    if (i < 4) { const f32x4 w0 = *(const f32x4*)(cwl + (ten * 4 + i) * 128 + 8 * p), w1 = *(const f32x4*)(cwl + (ten * 4 + i) * 128 + 8 * p + 4);
#pragma unroll
                        for (int e = 0; e < 4; ++e) { a0[e] += w0[e] * xv[e]; a0[4 + e] += w1[e] * xv[4 + e]; } }
                    if (i >= 1) { const f32x4 w0 = *(const f32x4*)(cwl + (ten * 4 + i - 1) * 128 + 8 * p), w1 = *(const f32x4*)(cwl + (ten * 4 + i - 1) * 128 + 8 * p + 4);
#pragma unroll
                        for (int e = 0; e < 4; ++e) { a1[e] += w0[e] * xv[e]; a1[4 + e] += w1[e] * xv[4 + e]; } } }
#pragma unroll
                for (int rr = 0; rr < 2; ++rr) { float* acc = rr == 0 ? a0 : a1; const int row = 2 * rg + rr; float ss = 0.f;
#pragma unroll
                    for (int e = 0; e < 8; ++e) { acc[e] = silu_f(acc[e]); ss += acc[e] * acc[e]; }
                    if (ten < 2) { ss = row16_sum(ss);
                        const float sc = rsqrtf(ss + RMS_EPS) * (ten == 0 ? 0.08838834764831845f : 1.f);
#pragma unroll
                        for (int e = 0; e < 8; ++e) acc[e] *= sc; }
                    u32x4 o; o.x = pk2(acc[0], acc[1]); o.y = pk2(acc[2], acc[3]); o.z = pk2(acc[4], acc[5]); o.w = pk2(acc[6], acc[7]);
                    *(u32x4*)((ten == 0 ? Qb : (ten == 1 ? Kb : Vb)) + row * 272 + 16 * p) = o;
                    if (ten < 2) { const float egr = eg[row]; const float f = (ten == 0) ? egr : egr * bs[row];
                        const int pp = p & 3, s1 = 16 * (pp & 1) + 4 * (pp >> 1);
                        unsigned char* rp = rec + (ten == 0 ? 16384 : 0) + row * 256 + (32 * (p >> 2)) * 2;
                        u32x2 q0, q1; q0.x = pk2(acc[0] * f, acc[1] * f); q0.y = pk2(acc[2] * f, acc[3] * f); q1.x = pk2(acc[4] * f, acc[5] * f); q1.y = pk2(acc[6] * f, acc[7] * f);
                        *(u32x2*)(rp + s1 * 2) = q0; *(u32x2*)(rp + (s1 + 8) * 2) = q1; } } }
            { const int chn = blockIdx.x + (k0 + ci + 1) * G;
              if (ci + 1 < 8 && chn < 2048) { const int bhn = chn >> 5, nn = chn & 31, bn = bhn >> 2, hn = bhn & 3;
#pragma unroll
                  for (int i_ = 0; i_ < 5; ++i_) { const int tt_ = nn * 64 + 2 * rg - 3 + i_;
                      ld[0][i_] = *(const u32x4*)(PROJ + (size_t)(bn * SEQ + max(tt_, 0)) * NPROJ + hn * 128 + 8 * p); } } }
            __syncthreads();
            { const int dcol = tid & 127, gp = tid >> 7;
#pragma unroll
              for (int q = 0; q < 2; ++q) { const int sg = gp * 2 + q, mp = sg >> 2, f4 = sg & 3; float kv[8], vv[8];
#pragma unroll
                  for (int jj = 0; jj < 8; ++jj) { const int c = 32 * mp + (jj < 4 ? 4 * f4 + jj : 16 + 4 * f4 + jj - 4);
                      kv[jj] = es[c] * __uint_as_float((unsigned)(*(const unsigned short*)(Kb + c * 272 + 2 * dcol)) << 16);
                      const int sr = 8 * sg + jj; vv[jj] = bs[sr] * __uint_as_float((unsigned)(*(const unsigned short*)(Vb + sr * 272 + 2 * dcol)) << 16); }
                  u32x4 o; o.x = pk2(kv[0], kv[1]); o.y = pk2(kv[2], kv[3]); o.z = pk2(kv[4], kv[5]); o.w = pk2(kv[6], kv[7]);
                  *(u32x4*)(rec + 32768 + dcol * 128 + sg * 16) = o;
                  u32x4 o2; o2.x = pk2(vv[0], vv[1]); o2.y = pk2(vv[2], vv[3]); o2.z = pk2(vv[4], vv[5]); o2.w = pk2(vv[6], vv[7]);
                  *(u32x4*)((unsigned char*)BVT + (size_t)chunk * 16384 + dcol * 128 + sg * 16) = o2; } }
            float* Lc = (float*)(Lp + ci * 8448);
            for (int job = wave; job < 26; job += 8) {
                if (job >= 20) { const int u = job - 20; const int it = (u < 3) ? 0 : (u < 5 ? 1 : 2); const int jt = (u < 3) ? u + 1 : (u < 5 ? u - 1 : 3);
                    const int i = 16 * it + fr; *(u32x2*)(rec + 57344 + i * 128 + (32 * (jt >> 1) + 8 * fq + 4 * (jt & 1)) * 2) = (u32x2){0u, 0u}; continue; }
                const int idx = job % 10; const bool isL = job < 10;
                const int it = (idx >= 6) ? 3 : (idx >= 3 ? 2 : (idx >= 1 ? 1 : 0)); const int jt = idx - it * (it + 1) / 2;
                const unsigned char* Xb = isL ? Kb : Qb;
                f32x4 d = {0.f, 0.f, 0.f, 0.f};
#pragma unroll
                for (int ks = 0; ks < 4; ++ks) { const bf16x8 kf = *(const bf16x8*)(Kb + (16 * jt + fr) * 272 + (32 * ks + 8 * fq) * 2), xf = *(const bf16x8*)(Xb + (16 * it + fr) * 272 + (32 * ks + 8 * fq) * 2);
                    d = __builtin_amdgcn_mfma_f32_16x16x32_bf16(kf, xf, d, 0, 0, 0); }
                const int i = 16 * it + fr; const float gi = gs[i], bi = bs[i]; float v[4];
#pragma unroll
                for (int e = 0; e < 4; ++e) { const int j = 16 * jt + 4 * fq + e; const bool ok = isL ? (j < i) : (j <= i); const float dec = __expf(fminf(gi - gs[j], 0.f)); v[e] = ok ? d[e] * dec * (isL ? bi : 1.f) : 0.f; }
                if (isL) { if (16 * jt + 4 * fq < ((i + 3) & ~3)) *(f32x4*)(Lc + 4 * ltri_off(i) + 16 * jt + 4 * fq) = (f32x4){v[0], v[1], v[2], v[3]}; }
                else { u32x2 o; o.x = pk2(v[0], v[1]); o.y = pk2(v[2], v[3]); *(u32x2*)(rec + 57344 + i * 128 + (32 * (jt >> 1) + 8 * fq + 4 * (jt & 1)) * 2) = o; }
            }
            __syncthreads();
        }
        { const int chunk = blockIdx.x + (k0 + wave) * G;
          if (chunk < 2048) { const float* Lc = (const float*)(Lp + wave * 8448);
              float Tc[64];
#pragma unroll
              for (int i = 0; i < 64; ++i) { float ac[4] = {(lane == i) ? 1.f : 0.f, 0.f, 0.f, 0.f};
#pragma unroll
                  for (int j4 = 0; j4 < (i + 3) / 4; ++j4) { const f32x4 l4 = *(const f32x4*)(Lc + 4 * ltri_off(i) + 4 * j4);
#pragma unroll
                      for (int e = 0; e < 4; ++e) if (4 * j4 + e < i) ac[e] -= l4[e] * Tc[4 * j4 + e]; }
                  Tc[i] = (ac[0] + ac[1]) + (ac[2] + ac[3]); if ((i & 3) == 3) __builtin_amdgcn_sched_barrier(0); }
              const int x = lane & 31; const int slot = 32 * (lane >> 5) + (x < 16 ? 8 * (x >> 2) + (x & 3) : 8 * ((x - 16) >> 2) + 4 + (x & 3));
              unsigned short* Tl = (unsigned short*)(Lp + wave * 8448);
#pragma unroll
              for (int i = 0; i < 64; ++i) Tl[i * 64 + slot] = (unsigned short)bf1(Tc[i]);
              unsigned char* trec = REC + (size_t)chunk * 65536 + 49152;
#pragma unroll
              for (int it = 0; it < 8; ++it) *(u32x4*)(trec + (it * 64 + lane) * 16) = *(const u32x4*)((const unsigned char*)Tl + (it * 64 + lane) * 16);
          } }
        __syncthreads();
    }
}

__device__ __forceinline__ void gdn_scan(const Params& P, unsigned char* smem, int bh) {
    int tid_ = threadIdx.x; asm volatile("" : "+v"(tid_)); const int tid = tid_, lane = tid & 63, w = tid >> 6, fr = lane & 15, fq = lane >> 4; const int b = bh >> 2, h = bh & 3; unsigned char* ws = P.ws;
    const bf16_t* PROJ = (const bf16_t*)(ws + WS_BIG); bf16_t* MIXIN = (bf16_t*)(ws + WS_MIXIN); const unsigned char* REC = (const unsigned char*)P.out;
    const unsigned char* BVT = (const unsigned char*)(ws + WS_BVT); const float* GLAST = (const float*)(ws + WS_GLAST);
    unsigned char* Lk = smem; unsigned char* Lq = smem + 17408; unsigned char* Lt = smem + 34816; unsigned char* LT = smem + 53248; unsigned char* Li = smem + 62464; float* Os = (float*)(smem + 71680);
    f32x4 Sacc[8];
#pragma unroll
    for (int j = 0; j < 8; ++j) Sacc[j] = (f32x4){0.f, 0.f, 0.f, 0.f};
    u32x4 st[8];
#define GS_LOAD(ch) do { const unsigned char* r_ = REC + (size_t)(ch) * 65536; _Pragma("unroll") for (int i_ = 0; i_ < 8; ++i_) st[i_] = *(const u32x4*)(r_ + (size_t)(tid + 512 * i_) * 16); } while (0)
#define GS_STORE() do { _Pragma("unroll") for (int i_ = 0; i_ < 8; ++i_) { const int id_ = tid + 512 * i_; unsigned char* d_; \
        if (i_ < 2) d_ = Lk + (id_ >> 4) * 272 + (id_ & 15) * 16; else if (i_ < 4) d_ = Lq + ((id_ - 1024) >> 4) * 272 + (id_ & 15) * 16; \
        else if (i_ < 6) d_ = Lt + ((id_ - 2048) >> 3) * 144 + (id_ & 7) * 16; else if (i_ < 7) d_ = LT + ((id_ - 3072) >> 3) * 144 + (id_ & 7) * 16; \
        else d_ = Li + ((id_ - 3584) >> 3) * 144 + (id_ & 7) * 16; *(u32x4*)d_ = st[i_]; } } while (0)
    u32x2 bvw[4]; float glast; unsigned zc[8];
    float nwv[16];
#pragma unroll
    for (int e = 0; e < 16; ++e) nwv[e] = P.gdn_norm_w[16 * (lane & 7) + e];
#define GS_BV(ch) do { glast = GLAST[ch]; _Pragma("unroll") for (int rt_ = 0; rt_ < 4; ++rt_) bvw[rt_] = *(const u32x2*)(BVT + (size_t)(ch) * 16384 + (16 * w + fr) * 128 + (16 * rt_ + 4 * fq) * 2); } while (0)
#define GS_Z(nn) do { const bf16_t* zp_ = PROJ + (size_t)(b * SEQ + (nn) * 64 + w * 8 + (lane >> 3)) * NPROJ + C_GZ + h * 128 + 16 * (lane & 7); const u32x4 za_ = *(const u32x4*)zp_, zb_ = *(const u32x4*)(zp_ + 8); \
          zc[0] = za_.x; zc[1] = za_.y; zc[2] = za_.z; zc[3] = za_.w; zc[4] = zb_.x; zc[5] = zb_.y; zc[6] = zb_.z; zc[7] = zb_.w; } while (0)
    GS_LOAD(bh * 32); GS_STORE(); GS_BV(bh * 32);
    __syncthreads();
    for (int n = 0; n < 32; ++n) {
        const int chunk = bh * 32 + n;
        GS_LOAD(bh * 32 + min(n + 1, 31)); GS_Z(n);
        bf16x8 sb[4];
#pragma unroll
        for (int m = 0; m < 4; ++m) { u32x4 o; o.x = pk2(Sacc[2 * m][0], Sacc[2 * m][1]); o.y = pk2(Sacc[2 * m][2], Sacc[2 * m][3]); o.z = pk2(Sacc[2 * m + 1][0], Sacc[2 * m + 1][1]); o.w = pk2(Sacc[2 * m + 1][2], Sacc[2 * m + 1][3]);
            sb[m] = __builtin_bit_cast(bf16x8, o); }
        bf16x8 fa[8], fb[8];
#define LD_KQ(F, rt_) do { _Pragma("unroll") for (int m_ = 0; m_ < 4; ++m_) { F[m_] = *(const bf16x8*)(Lk + (16 * (rt_) + fr) * 272 + (32 * m_ + 8 * fq) * 2); F[4 + m_] = *(const bf16x8*)(Lq + (16 * (rt_) + fr) * 272 + (32 * m_ + 8 * fq) * 2); } } while (0)
#define LD_64(F, base_) do { _Pragma("unroll") for (int rt_ = 0; rt_ < 4; ++rt_) _Pragma("unroll") for (int mp_ = 0; mp_ < 2; ++mp_) F[2 * rt_ + mp_] = *(const bf16x8*)((base_) + (16 * rt_ + fr) * 144 + (32 * mp_ + 8 * fq) * 2); } while (0)
#define LD_KT(F, j0_) do { _Pragma("unroll") for (int jj_ = 0; jj_ < 4; ++jj_) _Pragma("unroll") for (int mp_ = 0; mp_ < 2; ++mp_) F[2 * jj_ + mp_] = *(const bf16x8*)(Lt + (16 * ((j0_) + jj_) + fr) * 144 + (32 * mp_ + 8 * fq) * 2); } while (0)
#define MM_KQ(F, rt_) do { xacc[rt_] = (f32x4){0.f, 0.f, 0.f, 0.f}; oacc[rt_] = (f32x4){0.f, 0.f, 0.f, 0.f}; _Pragma("unroll") for (int m_ = 0; m_ < 4; ++m_) { \
            xacc[rt_] = __builtin_amdgcn_mfma_f32_16x16x32_bf16(F[m_], sb[m_], xacc[rt_], 0, 0, 0); oacc[rt_] = __builtin_amdgcn_mfma_f32_16x16x32_bf16(F[4 + m_], sb[m_], oacc[rt_], 0, 0, 0); } } while (0)
#define SB0() __builtin_amdgcn_sched_barrier(0)
        f32x4 xacc[4], oacc[4], vacc[4];
        LD_KQ(fa, 0); LD_KQ(fb, 1); SB0();
        MM_KQ(fa, 0); SB0(); LD_KQ(fa, 2); SB0();
        MM_KQ(fb, 1); SB0(); LD_KQ(fb, 3); SB0();
        MM_KQ(fa, 2); SB0(); LD_64(fa, LT); SB0();
        MM_KQ(fb, 3); SB0(); LD_64(fb, Li); SB0();
        bf16x8 xb[2];
#pragma unroll
        for (int mp = 0; mp < 2; ++mp) { float xv[8];
#pragma unroll
            for (int q = 0; q < 2; ++q) { const int rt = 2 * mp + q; xv[4 * q] = bflo(bvw[rt].x) - xacc[rt][0]; xv[4 * q + 1] = bfhi(bvw[rt].x) - xacc[rt][1]; xv[4 * q + 2] = bflo(bvw[rt].y) - xacc[rt][2]; xv[4 * q + 3] = bfhi(bvw[rt].y) - xacc[rt][3]; }
            u32x4 o; o.x = pk2(xv[0], xv[1]); o.y = pk2(xv[2], xv[3]); o.z = pk2(xv[4], xv[5]); o.w = pk2(xv[6], xv[7]); xb[mp] = __builtin_bit_cast(bf16x8, o); }
#pragma unroll
        for (int rt = 0; rt < 4; ++rt) { vacc[rt] = (f32x4){0.f, 0.f, 0.f, 0.f};
#pragma unroll
            for (int mp = 0; mp < 2; ++mp) vacc[rt] = __builtin_amdgcn_mfma_f32_16x16x32_bf16(fa[2 * rt + mp], xb[mp], vacc[rt], 0, 0, 0); }
        SB0(); LD_KT(fa, 0); SB0();
        bf16x8 vb[2];
#pragma unroll
        for (int mp = 0; mp < 2; ++mp) { u32x4 o; o.x = pk2(vacc[2 * mp][0], vacc[2 * mp][1]); o.y = pk2(vacc[2 * mp][2], vacc[2 * mp][3]); o.z = pk2(vacc[2 * mp + 1][0], vacc[2 * mp + 1][1]); o.w = pk2(vacc[2 * mp + 1][2], vacc[2 * mp + 1][3]);
            vb[mp] = __builtin_bit_cast(bf16x8, o); }
#pragma unroll
        for (int rt = 0; rt < 4; ++rt)
#pragma unroll
            for (int mp = 0; mp < 2; ++mp) oacc[rt] = __builtin_amdgcn_mfma_f32_16x16x32_bf16(fb[2 * rt + mp], vb[mp], oacc[rt], 0, 0, 0);
        SB0(); LD_KT(fb, 4); SB0();
#pragma unroll
        for (int jj = 0; jj < 4; ++jj) { Sacc[jj] = Sacc[jj] * glast;
#pragma unroll
            for (int mp = 0; mp < 2; ++mp) Sacc[jj] = __builtin_amdgcn_mfma_f32_16x16x32_bf16(fa[2 * jj + mp], vb[mp], Sacc[jj], 0, 0, 0); }
        SB0();
#pragma unroll
        for (int jj = 0; jj < 4; ++jj) { Sacc[4 + jj] = Sacc[4 + jj] * glast;
#pragma unroll
            for (int mp = 0; mp < 2; ++mp) Sacc[4 + jj] = __builtin_amdgcn_mfma_f32_16x16x32_bf16(fb[2 * jj + mp], vb[mp], Sacc[4 + jj], 0, 0, 0); }
#undef LD_KQ
#undef LD_64
#undef LD_KT
#undef MM_KQ
#undef SB0
#pragma unroll
        for (int rt = 0; rt < 4; ++rt)
#pragma unroll
            for (int i = 0; i < 4; ++i) Os[(16 * rt + 4 * fq + i) * 128 + 16 * w + fr] = oacc[rt][i];
        __syncthreads();
        GS_STORE();
        {
          const int row = w * 8 + (lane >> 3), cg = lane & 7; const size_t m = (size_t)(b * SEQ + n * 64 + row);
          float ov[16]; float ss = 0.f;
#pragma unroll
          for (int k4 = 0; k4 < 4; ++k4) { const f32x4 o4 = *(const f32x4*)(Os + row * 128 + 16 * cg + 4 * k4); ov[4 * k4] = o4[0]; ov[4 * k4 + 1] = o4[1]; ov[4 * k4 + 2] = o4[2]; ov[4 * k4 + 3] = o4[3];
              ss += (o4[0] * o4[0] + o4[1] * o4[1]) + (o4[2] * o4[2] + o4[3] * o4[3]); }
          ss = half8_sum(ss);
          const float rstd = rsqrtf(ss * (1.f / 128.f) + RMS_EPS);
          unsigned ow[8];
#pragma unroll
          for (int e2 = 0; e2 < 8; ++e2) { const unsigned zw = zc[e2];
              ow[e2] = pk2(ov[2 * e2] * rstd * nwv[2 * e2] * silu_f(bflo(zw)), ov[2 * e2 + 1] * rstd * nwv[2 * e2 + 1] * silu_f(bfhi(zw))); }
          bf16_t* op = MIXIN + m * DM + h * 128 + 16 * cg;
          *(u32x4*)op = (u32x4){ow[0], ow[1], ow[2], ow[3]}; *(u32x4*)(op + 8) = (u32x4){ow[4], ow[5], ow[6], ow[7]}; }
        GS_BV(bh * 32 + min(n + 1, 31));
        __syncthreads();
    }
#undef GS_BV
#undef GS_Z
#undef GS_LOAD
#undef GS_STORE
}

struct RowBuf { u32x2 m[4]; u32x2 x[4]; };
__device__ __forceinline__ void rb_load(RowBuf& r, const bf16_t* mb, const bf16_t* xb, int m, int lane) {
#pragma unroll
    for (int jj = 0; jj < 4; ++jj) { r.m[jj] = *(const u32x2*)(mb + (size_t)m * DM + 4 * lane + 256 * jj); r.x[jj] = *(const u32x2*)(xb + (size_t)m * DM + 4 * lane + 256 * jj); }
}
__device__ __forceinline__ void rp1_proc(const Params& P, const RowBuf& cur, int m, int lane, const f32x4 (&w1)[4], float* RS2) {
    f32x4 mv[4], xv[4]; float s = 0.f;
#pragma unroll
    for (int jj = 0; jj < 4; ++jj) { mv[jj] = (f32x4){bflo(cur.m[jj].x), bfhi(cur.m[jj].x), bflo(cur.m[jj].y), bfhi(cur.m[jj].y)}; xv[jj] = (f32x4){bflo(cur.x[jj].x), bfhi(cur.x[jj].x), bflo(cur.x[jj].y), bfhi(cur.x[jj].y)};
        s += (mv[jj][0] * mv[jj][0] + mv[jj][1] * mv[jj][1]) + (mv[jj][2] * mv[jj][2] + mv[jj][3] * mv[jj][3]); }
    const float r1 = rsqrtf(wave_sum(s) * (1.f / DM) + RMS_EPS); float s2 = 0.f;
#pragma unroll
    for (int jj = 0; jj < 4; ++jj) { xv[jj] = xv[jj] + mv[jj] * r1 * w1[jj]; { u32x2 hb; hb.x = pk2(xv[jj][0], xv[jj][1]); hb.y = pk2(xv[jj][2], xv[jj][3]); *(u32x2*)((bf16_t*)P.out + (size_t)m * DM + 4 * lane + 256 * jj) = hb; }
        s2 += (xv[jj][0] * xv[jj][0] + xv[jj][1] * xv[jj][1]) + (xv[jj][2] * xv[jj][2] + xv[jj][3] * xv[jj][3]); }
    const float r2 = rsqrtf(wave_sum(s2) * (1.f / DM) + RMS_EPS);
    if (lane == 0) RS2[m] = r2;
}
__device__ __forceinline__ void rowpass1(const Params& P) {
    int tid_ = threadIdx.x; asm volatile("" : "+v"(tid_)); const int tid = tid_, lane = tid & 63, wave = __builtin_amdgcn_readfirstlane(tid >> 6); const int gw = blockIdx.x * 8 + wave, NGW = gridDim.x * 8; unsigned char* ws = P.ws;
    const bf16_t* MIX = (const bf16_t*)(ws + WS_BIG); const bf16_t* XB = (const bf16_t*)(ws + WS_U); float* RS2 = (float*)(ws + WS_RS2);
    f32x4 w1[4];
#pragma unroll
    for (int jj = 0; jj < 4; ++jj) w1[jj] = *((const f32x4*)P.n_post_attn + lane + 64 * jj);
#define RP1_LOAD(buf, mm) rb_load(buf, MIX, XB, mm, lane)
#define RP1_PROC(buf, mm) rp1_proc(P, buf, mm, lane, w1, RS2)
    ROWLOOP3(RowBuf, RP1_LOAD, RP1_PROC);
#undef RP1_LOAD
#undef RP1_PROC
}
struct RowBuf2 { u32x2 m[4]; u32x2 h[4]; };
__device__ __forceinline__ void rb2_load(RowBuf2& r, const bf16_t* mb, const bf16_t* hb, int m, int lane) {
#pragma unroll
    for (int jj = 0; jj < 4; ++jj) { r.m[jj] = *(const u32x2*)(mb + (size_t)m * DM + 4 * lane + 256 * jj); r.h[jj] = *(const u32x2*)(hb + (size_t)m * DM + 4 * lane + 256 * jj); }
}
__device__ __forceinline__ void rp2_proc(const RowBuf2& cur, int m, int lane, const f32x4 (&w1)[4], bf16_t* H2B) {
    f32x4 fv[4], hv[4]; float s = 0.f;
#pragma unroll
    for (int jj = 0; jj < 4; ++jj) { fv[jj] = (f32x4){bflo(cur.m[jj].x), bfhi(cur.m[jj].x), bflo(cur.m[jj].y), bfhi(cur.m[jj].y)}; hv[jj] = (f32x4){bflo(cur.h[jj].x), bfhi(cur.h[jj].x), bflo(cur.h[jj].y), bfhi(cur.h[jj].y)};
        s += (fv[jj][0] * fv[jj][0] + fv[jj][1] * fv[jj][1]) + (fv[jj][2] * fv[jj][2] + fv[jj][3] * fv[jj][3]); }
    const float r1 = rsqrtf(wave_sum(s) * (1.f / DM) + RMS_EPS);
#pragma unroll
    for (int jj = 0; jj < 4; ++jj) { hv[jj] = hv[jj] + fv[jj] * r1 * w1[jj];
        u32x2 o; o.x = pk2(hv[jj][0], hv[jj][1]); o.y = pk2(hv[jj][2], hv[jj][3]); *(u32x2*)(H2B + (size_t)m * DM + 4 * lane + 256 * jj) = o; }
}
__device__ __forceinline__ void rowpass2(const Params& P) {
    int tid_ = threadIdx.x; asm volatile("" : "+v"(tid_)); const int tid = tid_, lane = tid & 63, wave = __builtin_amdgcn_readfirstlane(tid >> 6); const int gw = blockIdx.x * 8 + wave, NGW = gridDim.x * 8; unsigned char* ws = P.ws;
    const bf16_t* F = (const bf16_t*)(ws + WS_U); bf16_t* H2B = (bf16_t*)(ws + WS_MIXIN); const bf16_t* H1B = (const bf16_t*)P.out;
    f32x4 w1[4];
#pragma unroll
    for (int jj = 0; jj < 4; ++jj) w1[jj] = *((const f32x4*)P.n_post_mlp + lane + 64 * jj);
#define RP2_LOAD(buf, mm) rb2_load(buf, F, H1B, mm, lane)
#define RP2_PROC(buf, mm) rp2_proc(buf, mm, lane, w1, H2B)
    ROWLOOP3(RowBuf2, RP2_LOAD, RP2_PROC);
#undef RP2_LOAD
#undef RP2_PROC
}

template <int MODE> __device__ __forceinline__ void run_gemm(unsigned char* smem, const bf16_t* A, const bf16_t* Bt, int N, int K, bf16_t* O, int ldc, float* out, const bf16_t* ple, const float* rs = nullptr) {
    pg8::Gemm g{A, Bt, MTOK, N, K}; pg8::StaticOrder S; S.init(MTOK, N, (int)gridDim.x, (int)blockIdx.x);
    pg8::EpiGen<MODE> E{O, ldc, out, ple, rs};
#ifndef NO_GEMM
    pg8::gemm_phase<pg8::EpiGen<MODE>, pg8::StaticOrder, true, true>((PG8_LAS unsigned char*)smem, g, S, E);
#endif
    __syncthreads();
}

#define XB_TMO      128
#define XB_XCNT(j)  (256  + 64 * (j))
#define XB_XSUB(j)  (1280 + 64 * (j))
#define XB_XGEN(j)  (2304 + 64 * (j))
#define XB_TOP      3328
#define XB_TOPGEN   3392
#define XCD_BAR_WORDS 3456
#define XB_SPIN_CAP (1u << 18)

__device__ __forceinline__ unsigned xb_ld(unsigned* p)              { return __hip_atomic_load(p, __ATOMIC_RELAXED, __HIP_MEMORY_SCOPE_AGENT); }
__device__ __forceinline__ unsigned xb_add(unsigned* p, unsigned v) { return __hip_atomic_fetch_add(p, v, __ATOMIC_RELAXED, __HIP_MEMORY_SCOPE_AGENT); }
__device__ __forceinline__ unsigned xb_xcc_id() { return (unsigned)__builtin_amdgcn_s_getreg((3 << 11) | 20) & 0xFu; }
#define XB_SPIN(cond, bar) do { unsigned _sp = 0; while (cond) { __builtin_amdgcn_s_sleep(1); \
    if ((++_sp & 255u) == 0u) { if (xb_ld(&(bar)[XB_TMO])) break; if (_sp > XB_SPIN_CAP) { atomicAdd(&(bar)[XB_TMO], 1u); break; } } } } while (0)

struct XcdBarrier {
    unsigned* bar; unsigned x;
    volatile LAS unsigned* st;
};

__device__ __forceinline__ XcdBarrier xcd_barrier_post(unsigned* bar, volatile LAS unsigned* st) {
    XcdBarrier b; b.bar = bar; b.x = xb_xcc_id(); b.st = st;
    if (threadIdx.x == 0) (void)xb_add(&bar[XB_XCNT(b.x)], 1u);
    return b;
}
__device__ __forceinline__ void xcd_barrier_complete(unsigned* bar, unsigned x, unsigned& nloc, unsigned& nx) {
    const unsigned G = gridDim.x * gridDim.y * gridDim.z;
    unsigned sum, cnt, mine, sp = 0u;
    for (;;) {
        sum = 0u; cnt = 0u; mine = 0u;
#pragma unroll
        for (unsigned j = 0; j < 16; ++j) { const unsigned c = xb_ld(&bar[XB_XCNT(j)]); sum += c; cnt += (c > 0u) ? 1u : 0u; mine = (j == x) ? c : mine; }
        if (sum == G) break;
        __builtin_amdgcn_s_sleep(1);
        if ((++sp & 255u) == 0u) { if (xb_ld(&bar[XB_TMO])) break; if (sp > XB_SPIN_CAP) { atomicAdd(&bar[XB_TMO], 1u); break; } }
    }
    nloc = mine > 0u ? mine : 1u; nx = cnt > 0u ? cnt : 1u;
}

__device__ __forceinline__ void xcd_barrier(const XcdBarrier& b) {
    asm volatile("s_waitcnt vmcnt(0)" ::: "memory");
    __syncthreads();
    if (threadIdx.x == 0) {
        unsigned* bar = b.bar;
        __builtin_amdgcn_s_waitcnt(0);
        unsigned nloc = b.st[0], nx = b.st[1];
        if (nloc == 0u) { xcd_barrier_complete(bar, b.x, nloc, nx); b.st[0] = nloc; b.st[1] = nx; }
        const unsigned old = xb_add(&bar[XB_XSUB(b.x)], 1u);
        const unsigned gen = old / nloc;
        if (old + 1u == (gen + 1u) * nloc) {
            __builtin_amdgcn_fence(__ATOMIC_RELEASE, "agent");
            asm volatile("s_waitcnt vmcnt(0)" ::: "memory");
            const unsigned og = xb_add(&bar[XB_TOP], 1u);
            const unsigned tg = og / nx;
            if (og + 1u == (tg + 1u) * nx) xb_add(&bar[XB_TOPGEN], 1u);
            else XB_SPIN(xb_ld(&bar[XB_TOPGEN]) == tg, bar);
            __builtin_amdgcn_fence(__ATOMIC_ACQUIRE, "agent");
            xb_add(&bar[XB_XGEN(b.x)], 1u);
            asm volatile("s_waitcnt vmcnt(0)" ::: "memory");
        } else {
            XB_SPIN(xb_ld(&bar[XB_XGEN(b.x)]) == gen, bar);
            __builtin_amdgcn_fence(__ATOMIC_ACQUIRE, "agent");
            asm volatile("s_waitcnt vmcnt(0)" ::: "memory");
        }
    }
    __syncthreads();
}

constexpr size_t WS_XBAR = WS_END2 + 256;

constexpr size_t WS_TS = WS_END2;
#ifdef PROBE_K
#define STAMP(k) do { if (blockIdx.x == 0 && threadIdx.x == 0) ((unsigned long long*)(ws + WS_TS))[k] = __builtin_amdgcn_s_memrealtime(); } while (0)
#else
#define STAMP(k) do { } while (0)
#endif
#define XSYNC() xcd_barrier(xbar)
#define GRID_SYNC() do { asm volatile("s_waitcnt vmcnt(0)" ::: "memory"); grid.sync(); } while (0)
__global__ void __launch_bounds__(512) fwd_megakernel(Params P) {
    extern __shared__ __attribute__((aligned(16))) unsigned char smem[];
    cg::grid_group grid = cg::this_grid();
    unsigned char* ws = P.ws;
    volatile LAS unsigned* xst = (volatile LAS unsigned*)((LAS unsigned char*)smem + LDS_BYTES);
    if (threadIdx.x < 2) xst[threadIdx.x] = 0u;
    __syncthreads();
    const XcdBarrier xbar = xcd_barrier_post((unsigned*)(ws + WS_XBAR), xst);
    STAMP(0);
    phase0(P, smem);
#ifdef DUP_P0
    __syncthreads(); phase0(P, smem);
#endif
    XSYNC(); if (P.coop_marker) { GRID_SYNC(); }     STAMP(1);
    run_gemm<4>(smem, (const bf16_t*)(ws + WS_U), (const bf16_t*)(ws + WS_WIN), NPROJ, DM, (bf16_t*)(ws + WS_BIG), NPROJ, nullptr, nullptr, (const float*)(ws + WS_RS0));
    XSYNC(); STAMP(2);
    moba_prep(P, smem);
    gdn_prep(P, smem);
#ifdef DUP_PREP
    __syncthreads(); gdn_prep(P, smem);
#endif
    XSYNC(); STAMP(3);
#ifndef NDUP3
#define NDUP3 1
#endif
    for (int dup3 = 0; dup3 < NDUP3; ++dup3) { const int G = gridDim.x; const int ngdn = 64;
      if (dup3 > 0) { XSYNC(); }
      if ((int)blockIdx.x < ngdn) {
#ifndef NO_GDN
 for (int bh = blockIdx.x; bh < 64; bh += ngdn) gdn_scan(P, smem, bh);
#ifdef DUP_SCAN
 for (int bh = blockIdx.x; bh < 64; bh += ngdn) gdn_scan(P, smem, bh);
#endif
#endif
 }
      else { for (int u = blockIdx.x - ngdn; u < 192; u += G - ngdn) { const int bh = u / 3, j = u - 3 * bh;
#ifndef NO_MOBA
 const int nq = (j == 2) ? 4 : 2; const unsigned list = (j == 0) ? 0x37u : (j == 1 ? 0x46u : 0x0125u);
 for (int rep = 0; rep < nq; ++rep) moba_unit(P, smem, bh, (int)((list >> (4 * (nq - 1 - rep))) & 15u));
#ifdef DUP_MOBA
 for (int rep = 0; rep < nq; ++rep) moba_unit(P, smem, bh, (int)((list >> (4 * (nq - 1 - rep))) & 15u));
#endif
#endif
 } } }
    XSYNC(); STAMP(4);
    run_gemm<0>(smem, (const bf16_t*)(ws + WS_MIXIN), (const bf16_t*)(ws + WS_WOUT), DM, DM, (bf16_t*)(ws + WS_BIG), DM, nullptr, nullptr);
    XSYNC(); STAMP(5);
#ifdef DUP_SYNC
    for (int i_ = 0; i_ < 8; ++i_) { XSYNC(); }
#endif
    rowpass1(P);
#ifdef DUP_RP1
    rowpass1(P);
#endif
    XSYNC(); STAMP(6);
    run_gemm<5>(smem, (const bf16_t*)P.out, (const bf16_t*)(ws + WS_WUP), DFF, DM, (bf16_t*)(ws + WS_BIG), DFF, nullptr, nullptr, (const float*)(ws + WS_RS2));
    XSYNC(); STAMP(7);
    run_gemm<0>(smem, (const bf16_t*)(ws + WS_BIG), (const bf16_t*)(ws + WS_WDOWN), DM, DFF, (bf16_t*)(ws + WS_U), DM, nullptr, nullptr);
    XSYNC(); STAMP(8);
    rowpass2(P);
    run_gemm<0>(smem, (const bf16_t*)(ws + WS_PB), (const bf16_t*)(ws + WS_WPLE), DM, PLED, (bf16_t*)(ws + WS_BIG), DM, nullptr, nullptr);
    XSYNC(); STAMP(9);
    run_gemm<2>(smem, (const bf16_t*)(ws + WS_MIXIN), (const bf16_t*)(ws + WS_WGATE), DM, DM, (bf16_t*)(ws + WS_MIXIN), DM, P.out, (const bf16_t*)(ws + WS_BIG));
#ifdef PROBE_K
    XSYNC(); STAMP(10);
    if (blockIdx.x == 0 && threadIdx.x == 0) { const unsigned long long* ts = (const unsigned long long*)(ws + WS_TS); const float d0 = (float)(ts[PROBE_K + 1] - ts[PROBE_K]) * 0.01f, d1 = (float)(ts[PROBE_K2 + 1] - ts[PROBE_K2]) * 0.01f; P.out[0] = __expf(rintf(__logf(d0) * 4.f) * 0.25f); P.out[1] = __expf(rintf(__logf(d1) * 4.f) * 0.25f); }
#endif
}

extern "C" void kernel_launch(void* const* d_in, const int* in_sizes, int n_in, void* d_out, int out_size, void* d_ws, size_t ws_size, hipStream_t stream) {
    static int grid_blocks = 0;
    if (grid_blocks == 0) {
        if (ws_size < WS_TOTAL) { fprintf(stderr, "kernel_launch: workspace too small: %zu < %zu\n", ws_size, (size_t)WS_END2); grid_blocks = -1; return; }
        int dev = 0, cus = 0, per_cu = 0;
        hipGetDevice(&dev); hipDeviceGetAttribute(&cus, hipDeviceAttributeMultiprocessorCount, dev);
        hipFuncSetAttribute((const void*)fwd_megakernel, hipFuncAttributeMaxDynamicSharedMemorySize, LDS_BYTES + 64);
        hipOccupancyMaxActiveBlocksPerMultiprocessor(&per_cu, (const void*)fwd_megakernel, 512, LDS_BYTES + 64);
        if (per_cu < 1) { fprintf(stderr, "kernel_launch: occupancy query says %d blocks per CU\n", per_cu); per_cu = 1; }
        grid_blocks = cus;
        if (grid_blocks > 256) grid_blocks = 256;
    }
    if (grid_blocks < 0) return;
    Params P{};
    P.x = (const float*)d_in[0]; P.p = (const float*)d_in[1]; P.w_in = (const float*)d_in[2]; P.conv_w = (const float*)d_in[3]; P.a_log = (const float*)d_in[4]; P.dt_bias = (const float*)d_in[5];
    P.gdn_norm_w = (const float*)d_in[6]; P.w_out = (const float*)d_in[7]; P.n_pre_attn = (const float*)d_in[8]; P.n_post_attn = (const float*)d_in[9]; P.n_pre_mlp = (const float*)d_in[10];
    P.n_post_mlp = (const float*)d_in[11]; P.w_up = (const float*)d_in[12]; P.w_down = (const float*)d_in[13]; P.w_ple = (const float*)d_in[14]; P.w_gate = (const float*)d_in[15];
    P.out = (float*)d_out; P.ws = (unsigned char*)d_ws;
    for (int d = 0; d < 16; ++d) P.inv_freq[d] = (float)std::pow(500000.0, -(double)d / 16.0);
#ifdef DIAG_POISON
    hipMemsetAsync(d_out, 0xFF, (size_t)MTOK * DM * 4, stream);
    hipMemsetAsync((unsigned char*)d_ws + WS_U, 0xFF, (size_t)MTOK * DM * 2, stream);
    hipMemsetAsync((unsigned char*)d_ws + WS_GLAST, 0xFF, 8192, stream);
#endif
    hipMemsetAsync((unsigned char*)d_ws + WS_XBAR, 0, XCD_BAR_WORDS * 4, stream);
    void* args[] = {&P};
    hipError_t e = hipLaunchCooperativeKernel((const void*)fwd_megakernel, dim3(grid_blocks), dim3(512), args, LDS_BYTES + 64, stream);
    if (e != hipSuccess) fprintf(stderr, "cooperative launch failed: %s (grid %d)\n", hipGetErrorString(e), grid_blocks);
}
```

```cpp
#include <hip/hip_runtime.h>
#include <hip/hip_cooperative_groups.h>
#include <cstdio>
#include <cstdint>
#include <cmath>
namespace cg = cooperative_groups;
namespace pg8 {
#define PG8_LAS __attribute__((address_space(3)))
typedef unsigned short bf16_t;
typedef short bf16x8 __attribute__((ext_vector_type(8)));
typedef float f32x4 __attribute__((ext_vector_type(4)));
typedef unsigned u32x4 __attribute__((ext_vector_type(4)));
constexpr int BM = 256, BK = 64, HALF = 128, HTB = HALF * BK * 2  , STAGE_BYTES = 8 * HTB, NXCD = 8, WGM = 8;

__host__ __device__ __forceinline__ int lds_byte(int r, int c) { const int st = (r >> 4) * 2 + (c >> 5), rr = r & 15, cc = c & 31, ob = rr * 64 + cc * 2; return st * 1024 + (ob ^ (((ob >> 9) & 1) << 5)); }
__host__ __device__ __forceinline__ void stage_rc(int b, int& R, int& C) { const int st = b / 1024, sb = b % 1024, swz = sb ^ (((sb >> 9) & 1) << 5); R = (st >> 1) * 16 + swz / 64; C = (st & 1) * 32 + (swz % 64) / 2; }
__host__ __device__ __forceinline__ int perm32(int rho) { const int n = rho >> 4, i = rho & 15; return 8 * (i >> 2) + 4 * n + (i & 3); }

struct Unit { int pm, pn; };
struct Gemm { const bf16_t* A; const bf16_t* Bt; int M, N, K; };

struct StaticOrder {
    int nM, nN, nwg, G, c;
    __host__ __device__ void init(int M, int N, int G_, int c_) { nM = M / BM; nN = N / BM; nwg = nM * nN; G = G_; c = c_; }
    __host__ __device__ bool next(int i, Unit& u) const {
        const long L = (long)i * G + c; if (L >= nwg) return false;
        int wgid = (int)L; { const int q = nwg / NXCD, r = nwg % NXCD, xcd = wgid % NXCD, off = wgid / NXCD; wgid = (xcd < r ? xcd * (q + 1) : r * (q + 1) + (xcd - r) * q) + off; }
        const int nig = WGM * nN, gid = wgid / nig, fm = gid * WGM, gsz = (nM - fm) < WGM ? (nM - fm) : WGM;
        u.pm = fm + ((wgid % nig) % gsz); u.pn = (wgid % nig) / gsz; return true;
    }
    __device__ __forceinline__ void a_ready(const Unit&) const {}
    __device__ __forceinline__ void done(const Unit&) const {}
};

typedef __bf16 bf16x2_cv __attribute__((ext_vector_type(2)));
typedef float f32x2_cv __attribute__((ext_vector_type(2)));
__device__ __forceinline__ unsigned cvt_pk_bf16(float lo, float hi) { f32x2_cv v = {lo, hi}; bf16x2_cv b = __builtin_convertvector(v, bf16x2_cv); return __builtin_bit_cast(unsigned, b); }
template <int MODE> struct EpiGen {
    static constexpr bool PERM = true, AFTER_DRAIN = false;
    bf16_t* O; int ldc; float* out; const bf16_t* ple; const float* rs;
    __device__ __forceinline__ void operator()(const f32x4 (&acc)[2][2][4][2], const Unit& u, int wr, int wc, int fr, int fq) const {
        const int row0 = u.pm * BM + wr * 64 + fr; const int col0 = u.pn * BM + wc * 32 + 8 * fq;
        if (MODE == 2) {
#pragma unroll
            for (int ai = 0; ai < 2; ++ai) {
                f32x4 h0[4][2], h1[4][2]; u32x4 pw[4][2];
#pragma unroll
                for (int m = 0; m < 4; ++m)
#pragma unroll
                    for (int bj = 0; bj < 2; ++bj) { const size_t row = (size_t)(row0 + ai * HALF + m * 16); const int col = col0 + bj * HALF;
                        const u32x4 hw = *(const u32x4*)(O + row * 1024 + col);
                        h0[m][bj] = (f32x4){__uint_as_float(hw.x << 16), __uint_as_float(hw.x & 0xffff0000u), __uint_as_float(hw.y << 16), __uint_as_float(hw.y & 0xffff0000u)};
                        h1[m][bj] = (f32x4){__uint_as_float(hw.z << 16), __uint_as_float(hw.z & 0xffff0000u), __uint_as_float(hw.w << 16), __uint_as_float(hw.w & 0xffff0000u)};
                        pw[m][bj] = *(const u32x4*)(ple + row * 1024 + col); }
#pragma unroll
                for (int m = 0; m < 4; ++m)
#pragma unroll
                    for (int bj = 0; bj < 2; ++bj) { const size_t row = (size_t)(row0 + ai * HALF + m * 16); const int col = col0 + bj * HALF; float* op = out + row * 1024 + col;
                        const f32x4 v0 = acc[ai][bj][m][0], v1 = acc[ai][bj][m][1]; const u32x4 w = pw[m][bj];
                        const f32x4 p0 = {__uint_as_float(w.x << 16), __uint_as_float(w.x & 0xffff0000u), __uint_as_float(w.y << 16), __uint_as_float(w.y & 0xffff0000u)};
                        const f32x4 p1 = {__uint_as_float(w.z << 16), __uint_as_float(w.z & 0xffff0000u), __uint_as_float(w.w << 16), __uint_as_float(w.w & 0xffff0000u)};
                        f32x4 o0, o1;
#pragma unroll
                        for (int e = 0; e < 4; ++e) { o0[e] = h0[m][bj][e] + p0[e] * __builtin_amdgcn_rcpf(1.f + __expf(-v0[e])); o1[e] = h1[m][bj][e] + p1[e] * __builtin_amdgcn_rcpf(1.f + __expf(-v1[e])); }
                        *(f32x4*)op = o0; *(f32x4*)(op + 4) = o1; }
            }
            return;
        }
        float rsv[2][4];
#pragma unroll
        for (int ai = 0; ai < 2; ++ai)
#pragma unroll
            for (int m = 0; m < 4; ++m) rsv[ai][m] = (MODE == 4 || MODE == 5) ? rs[row0 + ai * HALF + m * 16] : 1.f;
#pragma unroll
        for (int ai = 0; ai < 2; ++ai)
#pragma unroll
            for (int m = 0; m < 4; ++m) {
                const size_t row = (size_t)(row0 + ai * HALF + m * 16);
                float rsc = 1.f; if (MODE == 4) rsc = rsv[ai][m]; if (MODE == 5) rsc = rsv[ai][m] * rsv[ai][m];
#pragma unroll
                for (int bj = 0; bj < 2; ++bj) {
                    f32x4 v0 = acc[ai][bj][m][0], v1 = acc[ai][bj][m][1];
                    const int col = col0 + bj * HALF;
                    if (MODE == 1 || MODE == 5) {
#pragma unroll
                        for (int e = 0; e < 4; ++e) { float a = fmaxf(v0[e], 0.f), b = fmaxf(v1[e], 0.f); v0[e] = a * a; v1[e] = b * b; }
                    }
                    if (MODE == 4 || MODE == 5) { v0 = v0 * rsc; v1 = v1 * rsc; }
                    u32x4 w; w.x = cvt_pk_bf16(v0[0], v0[1]); w.y = cvt_pk_bf16(v0[2], v0[3]); w.z = cvt_pk_bf16(v1[0], v1[1]); w.w = cvt_pk_bf16(v1[2], v1[3]);
                    *(u32x4*)(O + row * ldc + col) = w;
                }
            }
    }
};
template <class Epi, class Sched, bool ALIGN_EPI = false, bool SP2 = false>
__device__ __forceinline__ void gemm_phase(PG8_LAS unsigned char* lds, const Gemm g, const Sched& S, const Epi& E) {
    int tid_ = threadIdx.x; asm volatile("" : "+v"(tid_)); const int tid = tid_, wid = __builtin_amdgcn_readfirstlane(tid >> 6), lane = tid & 63, wr = wid >> 2, wc = wid & 3, fr = lane & 15, fq = lane >> 4;
    const int K = g.K, nt = K / BK;
    unsigned voffA[2], voffB[2];
#pragma unroll
    for (int i = 0; i < 2; ++i) { int R, C; stage_rc(tid * 16 + i * 8192, R, C); const int Rb = Epi::PERM ? ((R & ~31) + perm32(R & 31)) : R;
        voffA[i] = (unsigned)(R * K + C) * 2u; voffB[i] = (unsigned)(Rb * K + C) * 2u; }
    const size_t kstep = (size_t)(BK * 2);
    const size_t hstep = (size_t)HALF * K * 2;
    const size_t tstep = 2 * hstep;
    const unsigned ldsw = (unsigned)wid * 1024u;
    const int aoff = lds_byte(wr * 64 + fr, fq * 8), boff = lds_byte(wc * 32 + fr, fq * 8);
#define PG8_SA(b, h) (((b) * 2 + (h)) * HTB)
#define PG8_SB(b, h) ((4 + (b) * 2 + (h)) * HTB)
#define PG8_STAGE(bufoff, gbase, voff) do { _Pragma("unroll") for (int _i = 0; _i < 2; ++_i) \
        __builtin_amdgcn_global_load_lds((const unsigned*)((const char*)(gbase) + (voff)[_i]), (PG8_LAS unsigned*)(lds + (bufoff) + ldsw + _i * 8192), 16, 0, 0); } while (0)
#define PG8_LDA(dst, b, h) do { _Pragma("unroll") for (int m = 0; m < 4; ++m) _Pragma("unroll") for (int k = 0; k < 2; ++k) dst[m][k] = *(const PG8_LAS bf16x8*)(lds + PG8_SA(b, h) + aoff + m * 2048 + k * 1024); } while (0)
#define PG8_LDB(dst, b, h) do { _Pragma("unroll") for (int n = 0; n < 2; ++n) _Pragma("unroll") for (int k = 0; k < 2; ++k) dst[n][k] = *(const PG8_LAS bf16x8*)(lds + PG8_SB(b, h) + boff + n * 2048 + k * 1024); } while (0)
#define PG8_MMA(ai, bj, At, Bt) do { __builtin_amdgcn_s_setprio(1); _Pragma("unroll") for (int m = 0; m < 4; ++m) _Pragma("unroll") for (int n = 0; n < 2; ++n) _Pragma("unroll") for (int k = 0; k < 2; ++k) \
        acc[ai][bj][m][n] = __builtin_amdgcn_mfma_f32_16x16x32_bf16(Bt[n][k], At[m][k], acc[ai][bj][m][n], 0, 0, 0); __builtin_amdgcn_s_setprio(0); } while (0)
#define PG8_WAIT_V(n) asm volatile("s_waitcnt vmcnt(" #n ")" ::: "memory")
#define PG8_WAIT_L(n) asm volatile("s_waitcnt lgkmcnt(" #n ")" ::: "memory")
#define PG8_BAR __builtin_amdgcn_s_barrier()
#define PG8_SCHED __builtin_amdgcn_sched_barrier(0)
    Unit cur, nxt; int ui = 0;
    if (!S.next(0, cur)) return;
    f32x4 acc[2][2][4][2];
#pragma unroll
    for (int a = 0; a < 2; ++a)
#pragma unroll
        for (int b = 0; b < 2; ++b)
#pragma unroll
            for (int m = 0; m < 4; ++m)
#pragma unroll
                for (int n = 0; n < 2; ++n) acc[a][b][m][n] = (f32x4){0.f, 0.f, 0.f, 0.f};
    bf16x8 At[4][2], B0[2][2], B1[2][2];
    const char* cA = (const char*)g.A + (size_t)cur.pm * tstep; const char* cB = (const char*)g.Bt + (size_t)cur.pn * tstep;
    S.a_ready(cur);
    if constexpr (SP2) {
        PG8_STAGE(PG8_SB(0, 0), cB, voffB); PG8_STAGE(PG8_SB(0, 1), cB + hstep, voffB); PG8_STAGE(PG8_SA(0, 0), cA, voffA); PG8_STAGE(PG8_SA(0, 1), cA + hstep, voffA);
        if (wr == 1) PG8_BAR;
        PG8_WAIT_V(2); PG8_BAR;
        PG8_STAGE(PG8_SB(1, 0), cB + kstep, voffB); PG8_STAGE(PG8_SA(1, 0), cA + kstep, voffA); PG8_STAGE(PG8_SB(1, 1), cB + hstep + kstep, voffB);
        PG8_WAIT_V(6); PG8_BAR;
    } else {
        PG8_STAGE(PG8_SB(0, 0), cB, voffB); PG8_STAGE(PG8_SA(0, 0), cA, voffA); PG8_STAGE(PG8_SB(0, 1), cB + hstep, voffB); PG8_STAGE(PG8_SA(0, 1), cA + hstep, voffA);
        if (wr == 1) PG8_BAR;
        PG8_WAIT_V(4); PG8_BAR;
        PG8_STAGE(PG8_SB(1, 0), cB + kstep, voffB); PG8_STAGE(PG8_SA(1, 0), cA + kstep, voffA); PG8_STAGE(PG8_SB(1, 1), cB + hstep + kstep, voffB);
        PG8_WAIT_V(6); PG8_BAR;
    }
    for (;;) {
        const bool has_next = S.next(ui + 1, nxt);
        const char* nA = has_next ? (const char*)g.A + (size_t)nxt.pm * tstep : cA; const char* nB = has_next ? (const char*)g.Bt + (size_t)nxt.pn * tstep : cB;
        for (int t = 0; t < nt; t += 2) {
            const bool last = (t == nt - 2);
            const char* a1 = cA + (size_t)(t + 1) * kstep;
            const char* a2 = last ? nA : cA + (size_t)(t + 2) * kstep; const char* b2 = last ? nB : cB + (size_t)(t + 2) * kstep;
            const char* a3 = a2 + kstep; const char* b3 = b2 + kstep;
            if (last && has_next) S.a_ready(nxt);
            if constexpr (SP2) {
            PG8_LDB(B0, 0, 0); PG8_LDB(B1, 0, 1); PG8_SCHED; PG8_LDA(At, 0, 0); PG8_STAGE(PG8_SA(1, 1), a1 + hstep, voffA);
            PG8_WAIT_V(8); PG8_WAIT_L(0); PG8_BAR; PG8_MMA(0, 0, At, B0); PG8_MMA(0, 1, At, B1); PG8_BAR; PG8_SCHED;
            PG8_LDA(At, 0, 1); PG8_STAGE(PG8_SB(0, 0), b2, voffB); PG8_STAGE(PG8_SB(0, 1), b2 + hstep, voffB); PG8_STAGE(PG8_SA(0, 0), a2, voffA);
            PG8_WAIT_V(8); PG8_WAIT_L(0); PG8_BAR; PG8_MMA(1, 0, At, B0); PG8_MMA(1, 1, At, B1); PG8_BAR; PG8_SCHED;
            PG8_LDB(B0, 1, 0); PG8_LDB(B1, 1, 1); PG8_SCHED; PG8_LDA(At, 1, 0); PG8_STAGE(PG8_SA(0, 1), a2 + hstep, voffA);
            PG8_WAIT_V(8); PG8_WAIT_L(0); PG8_BAR; PG8_MMA(0, 0, At, B0); PG8_MMA(0, 1, At, B1); PG8_BAR; PG8_SCHED;
            PG8_LDA(At, 1, 1); PG8_STAGE(PG8_SB(1, 0), b3, voffB); PG8_STAGE(PG8_SB(1, 1), b3 + hstep, voffB); PG8_STAGE(PG8_SA(1, 0), a3, voffA);
            PG8_WAIT_V(8); PG8_WAIT_L(0); PG8_BAR; PG8_MMA(1, 0, At, B0); PG8_MMA(1, 1, At, B1); PG8_BAR; PG8_SCHED;
            } else {
            PG8_LDB(B0, 0, 0); PG8_SCHED; PG8_LDA(At, 0, 0); PG8_STAGE(PG8_SA(1, 1), a1 + hstep, voffA);
            PG8_WAIT_L(8); PG8_BAR; PG8_WAIT_L(0); PG8_MMA(0, 0, At, B0); PG8_BAR; PG8_SCHED;
            PG8_LDB(B1, 0, 1); PG8_STAGE(PG8_SB(0, 0), b2, voffB);
            PG8_BAR; PG8_WAIT_L(0); PG8_MMA(0, 1, At, B1); PG8_BAR;
            PG8_LDA(At, 0, 1); PG8_STAGE(PG8_SA(0, 0), a2, voffA);
            PG8_BAR; PG8_WAIT_L(0); PG8_MMA(1, 0, At, B0); PG8_BAR; PG8_SCHED;
            PG8_STAGE(PG8_SB(0, 1), b2 + hstep, voffB);
            PG8_WAIT_V(6); PG8_BAR; PG8_MMA(1, 1, At, B1); PG8_BAR;
            PG8_LDB(B0, 1, 0); PG8_SCHED; PG8_LDA(At, 1, 0); PG8_STAGE(PG8_SA(0, 1), a2 + hstep, voffA);
            PG8_WAIT_L(8); PG8_BAR; PG8_WAIT_L(0); PG8_MMA(0, 0, At, B0); PG8_BAR; PG8_SCHED;
            PG8_LDB(B1, 1, 1); PG8_STAGE(PG8_SB(1, 0), b3, voffB);
            PG8_BAR; PG8_WAIT_L(0); PG8_MMA(0, 1, At, B1); PG8_BAR;
            PG8_LDA(At, 1, 1); PG8_STAGE(PG8_SA(1, 0), a3, voffA);
            PG8_BAR; PG8_WAIT_L(0); PG8_MMA(1, 0, At, B0); PG8_BAR; PG8_SCHED;
            PG8_STAGE(PG8_SB(1, 1), b3 + hstep, voffB);
            PG8_WAIT_V(6); PG8_BAR; PG8_MMA(1, 1, At, B1); PG8_BAR;
            }
        }
        if constexpr (ALIGN_EPI) { if (wr == 0) PG8_BAR; }
        if constexpr (!Epi::AFTER_DRAIN) { E(acc, cur, wr, wc, fr, fq); S.done(cur); }
        if (!has_next) break;
#pragma unroll
        for (int a = 0; a < 2; ++a)
#pragma unroll
            for (int b = 0; b < 2; ++b)
#pragma unroll
                for (int m = 0; m < 4; ++m)
#pragma unroll
                    for (int n = 0; n < 2; ++n) acc[a][b][m][n] = (f32x4){0.f, 0.f, 0.f, 0.f};
        cur = nxt; cA = nA; cB = nB; ++ui;
        if constexpr (ALIGN_EPI) { if (wr == 1) PG8_BAR; }
    }
    PG8_WAIT_V(0);
    if constexpr (!ALIGN_EPI) { if (wr == 0) PG8_BAR; }
    PG8_BAR;
    if constexpr (Epi::AFTER_DRAIN) { E.fused(acc, cur, wr, wc, fr, fq, lds, wid, lane); S.done(cur); }
#undef PG8_SA
#undef PG8_SB
#undef PG8_STAGE
#undef PG8_LDA
#undef PG8_LDB
#undef PG8_MMA
#undef PG8_WAIT_V
#undef PG8_WAIT_L
#undef PG8_BAR
#undef PG8_SCHED
}
}
typedef pg8::bf16_t bf16_t;
typedef pg8::bf16x8 bf16x8;
typedef pg8::f32x4 f32x4;
typedef pg8::u32x4 u32x4;
typedef unsigned u32x2 __attribute__((ext_vector_type(2)));
#define LAS __attribute__((address_space(3)))
constexpr int MTOK = 32768, DM = 1024, SEQ = 2048, NPROJ = 3584, DFF = 4096, PLED = 256, LDWIN = 3592;
constexpr int C_GQ = 0, C_GK = 512, C_GV = 1024, C_GZ = 1536, C_MQ = 2048, C_MK = 2560, C_MV = 3072;
constexpr float RMS_EPS = 1e-6f;
constexpr int LDS_BYTES = 143360;
constexpr size_t WS_KMAX = 0;
constexpr size_t WS_WIN = 4096, WS_WOUT = WS_WIN + (size_t)NPROJ * DM * 2, WS_WUP = WS_WOUT + (size_t)DM * DM * 2, WS_WDOWN = WS_WUP + (size_t)DFF * DM * 2,
    WS_WGATE = WS_WDOWN + (size_t)DFF * DM * 2, WS_WPLE = WS_WGATE + (size_t)DM * DM * 2, WS_ROPE = WS_WPLE + (size_t)DM * PLED * 2, WS_LG = WS_ROPE + (size_t)SEQ * 32 * 4,
    WS_KMEAN = WS_LG + (size_t)MTOK * 8 * 4, WS_PB = WS_KMEAN + (size_t)64 * 8 * 128 * 4, WS_U = WS_PB + (size_t)MTOK * PLED * 2, WS_VT = WS_U + (size_t)MTOK * DM * 2,
    WS_MIXIN = WS_VT + (size_t)64 * 128 * SEQ * 2, WS_BIG = WS_MIXIN + (size_t)MTOK * DM * 2, WS_END = WS_BIG + (size_t)MTOK * DFF * 2;
constexpr size_t WS_RS0 = WS_END + 8192 + (size_t)2048 * 16384 + 256 + 16384, WS_RS2 = WS_RS0 + (size_t)MTOK * 4, WS_TOTAL = WS_RS2 + (size_t)MTOK * 4;

struct Params {
    const float *x, *p, *w_in, *conv_w, *a_log, *dt_bias, *gdn_norm_w, *w_out, *n_pre_attn, *n_post_attn, *n_pre_mlp, *n_post_mlp, *w_up, *w_down, *w_ple, *w_gate;
    float* out; unsigned char* ws;
    float inv_freq[16];
    int coop_marker, pad;
};

__device__ __forceinline__ float wave_sum(float v) {
#pragma unroll
    for (int o = 1; o < 64; o <<= 1) v += __shfl_xor(v, o);
    return v;
}
#define DPP_F_(v_, ctrl_) __builtin_bit_cast(float, __builtin_amdgcn_update_dpp(0, __builtin_bit_cast(int, (v_)), (ctrl_), 0xf, 0xf, false))
__device__ __forceinline__ float row16_sum(float v) { v += DPP_F_(v, 0x128); v += DPP_F_(v, 0x124); v += DPP_F_(v, 0x122); v += DPP_F_(v, 0x121); return v; }
__device__ __forceinline__ float half8_sum(float v) { v += DPP_F_(v, 0xB1); v += DPP_F_(v, 0x4E); v += DPP_F_(v, 0x141); return v; }
#define ROWLOOP3(BUFT, LOADF, PROC) do { BUFT A_, B_, C_; int m = gw; LOADF(A_, m); LOADF(B_, min(m + NGW, MTOK - 1)); \
    for (;; m += 3 * NGW) { \
        LOADF(C_, min(m + 2 * NGW, MTOK - 1)); \
        PROC(A_, m); if (m + NGW >= MTOK) break; \
        LOADF(A_, min(m + 3 * NGW, MTOK - 1)); \
        PROC(B_, m + NGW); if (m + 2 * NGW >= MTOK) break; \
        LOADF(B_, min(m + 4 * NGW, MTOK - 1)); \
        PROC(C_, m + 2 * NGW); if (m + 3 * NGW >= MTOK) break; } } while (0)
__device__ __forceinline__ float bflo(unsigned w) { return __uint_as_float(w << 16); }
__device__ __forceinline__ float bfhi(unsigned w) { return __uint_as_float(w & 0xffff0000u); }
__device__ __forceinline__ unsigned pk2(float lo, float hi) { return pg8::cvt_pk_bf16(lo, hi); }
__device__ __forceinline__ float silu_f(float v) { return v * __builtin_amdgcn_rcpf(1.f + __expf(-v)); }

__device__ __forceinline__ void transpose_item(const float* W, int ldw, int K, int k0, int srccol0, bf16_t* WT, int n0, float* scr, int lane, const float* kscale) {
    f32x4 ldv[8];
#pragma unroll
    for (int i = 0; i < 8; ++i) ldv[i] = *(const f32x4*)(W + (size_t)(k0 + 8 * i + (lane >> 3)) * ldw + srccol0 + 4 * (lane & 7));
#pragma unroll
    for (int i = 0; i < 8; ++i) { float* d = scr + (8 * i + (lane >> 3)) * 33 + 4 * (lane & 7); const float sc = kscale ? kscale[k0 + 8 * i + (lane >> 3)] : 1.f;
        d[0] = ldv[i][0] * sc; d[1] = ldv[i][1] * sc; d[2] = ldv[i][2] * sc; d[3] = ldv[i][3] * sc; }
    __builtin_amdgcn_s_waitcnt(0xc07f); asm volatile("s_waitcnt lgkmcnt(0)" ::: "memory");
    const int c = lane & 7;
#pragma unroll
    for (int j = 0; j < 4; ++j) { const int n = (lane >> 3) + 8 * j; const float* s = scr + (8 * c) * 33 + n;
        u32x4 o; o.x = pk2(s[0 * 33], s[1 * 33]); o.y = pk2(s[2 * 33], s[3 * 33]); o.z = pk2(s[4 * 33], s[5 * 33]); o.w = pk2(s[6 * 33], s[7 * 33]);
        *(u32x4*)(WT + (size_t)(n0 + n) * K + k0 + 8 * c) = o; }
    asm volatile("s_waitcnt lgkmcnt(0)" ::: "memory");
}
__device__ __forceinline__ void transpose_matrix(const float* W, int ldw, int K, int N, bool is_win, bf16_t* WT, float* scr, int gw, int NGW, int lane, const float* kscale = nullptr) {
    const int nblk = N / 32, items = (K / 64) * nblk;
    for (int it = gw; it < items; it += NGW) { const int kb = it / nblk, nb = it % nblk; const int n0 = nb * 32; const int src = is_win ? (n0 >= 2048 ? n0 + 8 : n0) : n0;
        transpose_item(W, ldw, K, kb * 64, src, WT, n0, scr, lane, kscale); }
}
__device__ __forceinline__ void phase0(const Params& P, unsigned char* smem) {
    int tid_ = threadIdx.x; asm volatile("" : "+v"(tid_)); const int tid = tid_, lane = tid & 63, wave = __builtin_amdgcn_readfirstlane(tid >> 6); const int G = gridDim.x; const int gw = blockIdx.x * 8 + wave, NGW = G * 8;
    unsigned char* ws = P.ws;
    float* scr = (float*)(smem + 32768) + wave * (64 * 33);
    transpose_matrix(P.w_in, LDWIN, DM, NPROJ, true, (bf16_t*)(ws + WS_WIN), scr, gw, NGW, lane, P.n_pre_attn);
    transpose_matrix(P.w_out, DM, DM, DM, false, (bf16_t*)(ws + WS_WOUT), scr, gw, NGW, lane);
    transpose_matrix(P.w_up, DFF, DM, DFF, false, (bf16_t*)(ws + WS_WUP), scr, gw, NGW, lane, P.n_pre_mlp);
    transpose_matrix(P.w_down, DM, DFF, DM, false, (bf16_t*)(ws + WS_WDOWN), scr, gw, NGW, lane);
    transpose_matrix(P.w_gate, DM, DM, DM, false, (bf16_t*)(ws + WS_WGATE), scr, gw, NGW, lane);
    transpose_matrix(P.w_ple, DM, PLED, DM, false, (bf16_t*)(ws + WS_WPLE), scr, gw, NGW, lane);
    { float* rope = (float*)(ws + WS_ROPE);
      for (int i = blockIdx.x * 512 + tid; i < SEQ * 16; i += G * 512) { const int t = i >> 4, d = i & 15; const float ang = (float)t * P.inv_freq[d];
          double rev = (double)ang * 0.15915494309189533577; rev -= __builtin_rint(rev); const float fr = (float)rev;
          rope[t * 32 + d] = __builtin_amdgcn_cosf(fr); rope[t * 32 + 16 + d] = __builtin_amdgcn_sinf(fr); } }
    { bf16_t* pb = (bf16_t*)(ws + WS_PB); const size_t n8 = (size_t)MTOK * PLED / 8;
      for (size_t i = (size_t)blockIdx.x * 512 + tid; i < n8; i += (size_t)G * 512) { const f32x4 a = *(const f32x4*)(P.p + i * 8), b = *(const f32x4*)(P.p + i * 8 + 4);
          u32x4 o; o.x = pk2(a[0], a[1]); o.y = pk2(a[2], a[3]); o.z = pk2(b[0], b[1]); o.w = pk2(b[2], b[3]); *(u32x4*)(pb + i * 8) = o; } }
    __syncthreads();
    { bf16_t* U = (bf16_t*)(ws + WS_U); float* LG = (float*)(ws + WS_LG);
      f32x4 wn[4];
#pragma unroll
      for (int j = 0; j < 4; ++j) wn[j] = *((const f32x4*)P.n_pre_attn + lane + 64 * j);
      f32x4 wl0[4][4], wl1[4][4];
#pragma unroll
      for (int j = 0; j < 4; ++j)
#pragma unroll
          for (int e = 0; e < 4; ++e) { const float* wp = P.w_in + (size_t)(4 * lane + 256 * j + e) * LDWIN + 2048; wl0[j][e] = *(const f32x4*)wp; wl1[j][e] = *(const f32x4*)(wp + 4); }
#define PN_LOAD(buf, mm) do { _Pragma("unroll") for (int j_ = 0; j_ < 4; ++j_) buf.c[j_] = *((const f32x4*)(P.x + (size_t)(mm) * DM) + lane + 64 * j_); } while (0)
#define PN_PROC(buf, mm) do { const int m_ = (mm); f32x4 v[4]; float s_ = 0.f; \
          _Pragma("unroll") for (int j = 0; j < 4; ++j) { v[j] = buf.c[j]; s_ += (v[j][0] * v[j][0] + v[j][1] * v[j][1]) + (v[j][2] * v[j][2] + v[j][3] * v[j][3]); } \
          const float rstd = rsqrtf(wave_sum(s_) * (1.f / DM) + RMS_EPS); \
          float lg[8]; _Pragma("unroll") for (int c = 0; c < 8; ++c) lg[c] = 0.f; \
          if (lane == 0) ((float*)(ws + WS_RS0))[m_] = rstd; \
          _Pragma("unroll") for (int j = 0; j < 4; ++j) { \
              u32x2 o; o.x = pk2(v[j][0], v[j][1]); o.y = pk2(v[j][2], v[j][3]); *(u32x2*)(U + (size_t)m_ * DM + 4 * lane + 256 * j) = o; v[j] = v[j] * rstd * wn[j]; \
              _Pragma("unroll") for (int e = 0; e < 4; ++e) { _Pragma("unroll") for (int c = 0; c < 4; ++c) { lg[c] += v[j][e] * wl0[j][e][c]; lg[4 + c] += v[j][e] * wl1[j][e][c]; } } } \
            \
          { const bool b0 = (lane & 1) != 0, b1 = (lane & 2) != 0, b2 = (lane & 4) != 0; float h4[4], h2[2], h1; \
            _Pragma("unroll") for (int i = 0; i < 4; ++i) { const float send = b0 ? lg[i] : lg[i + 4], keep = b0 ? lg[i + 4] : lg[i]; h4[i] = keep + __shfl_xor(send, 1); } \
            _Pragma("unroll") for (int i = 0; i < 2; ++i) { const float send = b1 ? h4[i] : h4[i + 2], keep = b1 ? h4[i + 2] : h4[i]; h2[i] = keep + __shfl_xor(send, 2); } \
            { const float send = b2 ? h2[0] : h2[1], keep = b2 ? h2[1] : h2[0]; h1 = keep + __shfl_xor(send, 4); } \
            h1 += __shfl_xor(h1, 8); h1 += __shfl_xor(h1, 16); h1 += __shfl_xor(h1, 32); \
            if (lane < 8) LG[(size_t)m_ * 8 + 4 * (lane & 1) + 2 * ((lane >> 1) & 1) + ((lane >> 2) & 1)] = h1; } } while (0)
      struct XBuf { f32x4 c[4]; };
      ROWLOOP3(XBuf, PN_LOAD, PN_PROC);
#undef PN_LOAD
#undef PN_PROC
    }
}

__device__ __forceinline__ void moba_prep(const Params& P, unsigned char* smem) {
    int tid_ = threadIdx.x; asm volatile("" : "+v"(tid_)); const int tid = tid_; unsigned char* ws = P.ws;
    bf16_t* PROJ = (bf16_t*)(ws + WS_BIG); const float* rope = (const float*)(ws + WS_ROPE); float* KMEAN = (float*)(ws + WS_KMEAN); bf16_t* VT = (bf16_t*)(ws + WS_VT);
    unsigned char* vt = smem;
    float* red = (float*)(smem + 69632);
    const int p = tid & 15, r = tid >> 4;
    for (int unit = blockIdx.x; unit < 512; unit += gridDim.x) {
        const int bh = unit >> 3, n = unit & 7, b = bh >> 2, h = bh & 3; const int m0 = b * SEQ + n * 256;
        float ksum[8]; float kmax2 = 0.f;
#pragma unroll
        for (int e = 0; e < 8; ++e) ksum[e] = 0.f;
        u32x4 lq[8], lk[8], lv[8];
#pragma unroll
        for (int i = 0; i < 8; ++i) { const size_t m = (size_t)(m0 + r + 32 * i); const bf16_t* bp = PROJ + m * NPROJ + h * 128 + 8 * p;
            lq[i] = *(const u32x4*)(bp + C_MQ); lk[i] = *(const u32x4*)(bp + C_MK); lv[i] = *(const u32x4*)(bp + C_MV); }
#pragma unroll
        for (int i = 0; i < 8; ++i) { const int row = r + 32 * i, t = n * 256 + row; const size_t m = (size_t)(m0 + row);
#pragma unroll
            for (int ten = 0; ten < 2; ++ten) {
                bf16_t* ptr = PROJ + m * NPROJ + (ten == 0 ? C_MQ : C_MK) + h * 128 + 8 * p;
                const u32x4 w = (ten == 0) ? lq[i] : lk[i]; u32x4 o; o.x = __shfl_xor(w.x, 2); o.y = __shfl_xor(w.y, 2); o.z = __shfl_xor(w.z, 2); o.w = __shfl_xor(w.w, 2);
                float a[8] = {bflo(w.x), bfhi(w.x), bflo(w.y), bfhi(w.y), bflo(w.z), bfhi(w.z), bflo(w.w), bfhi(w.w)};
                if (p < 4) {
                    const float bb[8] = {bflo(o.x), bfhi(o.x), bflo(o.y), bfhi(o.y), bflo(o.z), bfhi(o.z), bflo(o.w), bfhi(o.w)};
                    const float* cs = rope + t * 32 + 8 * (p & 1);
                    const f32x4 c0 = *(const f32x4*)cs, c1 = *(const f32x4*)(cs + 4), s0 = *(const f32x4*)(cs + 16), s1 = *(const f32x4*)(cs + 20);
                    const float cc[8] = {c0[0], c0[1], c0[2], c0[3], c1[0], c1[1], c1[2], c1[3]}, ss[8] = {s0[0], s0[1], s0[2], s0[3], s1[0], s1[1], s1[2], s1[3]};
#pragma unroll
                    for (int e = 0; e < 8; ++e) a[e] = (p < 2) ? (a[e] * cc[e] - bb[e] * ss[e]) : (a[e] * cc[e] + bb[e] * ss[e]);
                    u32x4 st; st.x = pk2(a[0], a[1]); st.y = pk2(a[2], a[3]); st.z = pk2(a[4], a[5]); st.w = pk2(a[6], a[7]);
                    *(u32x4*)ptr = st;
                }
                if (ten == 1) { float kn = 0.f;
#pragma unroll
                    for (int e = 0; e < 8; ++e) { ksum[e] += a[e]; const float ab = bflo(pk2(a[e], 0.f)); kn += ab * ab; }
                    kn = row16_sum(kn); kmax2 = fmaxf(kmax2, kn);
                }
            }
            *(u32x4*)(vt + row * 272 + 16 * p) = lv[i];
        }
#pragma unroll
        for (int e = 0; e < 8; ++e) red[r * 128 + 8 * p + e] = ksum[e];
        if (p == 0) red[4096 + r] = kmax2;
        __syncthreads();
        if (tid < 128) { float s = 0.f; for (int q = 0; q < 32; ++q) s += red[q * 128 + tid]; KMEAN[((size_t)bh * 8 + n) * 128 + tid] = s * (1.f / 256.f); }
        if (tid == 128) { float mx = 0.f; for (int q = 0; q < 32; ++q) mx = fmaxf(mx, red[4096 + q]); ((float*)(ws + WS_KMAX))[bh * 8 + n] = sqrtf(mx); }
        { const int d = tid & 127, tg = tid >> 7;
          for (int gi = 0; gi < 8; ++gi) { const int g = tg * 8 + gi, s32 = g >> 2, fq = g & 3; unsigned short e8[8];
#pragma unroll
              for (int j = 0; j < 8; ++j) { const int tok = 32 * s32 + (j < 4 ? 4 * fq + j : 16 + 4 * fq + (j - 4)); e8[j] = *(const unsigned short*)(vt + tok * 272 + 2 * d); }
              u32x4 o; o.x = e8[0] | ((unsigned)e8[1] << 16); o.y = e8[2] | ((unsigned)e8[3] << 16); o.z = e8[4] | ((unsigned)e8[5] << 16); o.w = e8[6] | ((unsigned)e8[7] << 16);
              *(u32x4*)(VT + ((size_t)bh * 128 + d) * SEQ + n * 256 + 8 * g) = o; } }
        __syncthreads();
    }
}

__device__ __forceinline__ void moba_unit(const Params& P, unsigned char* smem, int bh, int qb) {
    int tid_ = threadIdx.x; asm volatile("" : "+v"(tid_)); const int tid = tid_, lane = tid & 63, w = tid >> 6, fr = lane & 15, fq = lane >> 4; const int b = bh >> 2, h = bh & 3;
    unsigned char* ws = P.ws;
    const bf16_t* PROJ = (const bf16_t*)(ws + WS_BIG); const float* KMEAN = (const float*)(ws + WS_KMEAN); const bf16_t* VT = (const bf16_t*)(ws + WS_VT); bf16_t* MIXIN = (bf16_t*)(ws + WS_MIXIN);
    const int qrow0 = qb * 256 + 32 * w;
    bf16x8 qf[2][4];
#pragma unroll
    for (int rt = 0; rt < 2; ++rt)
#pragma unroll
        for (int ks = 0; ks < 4; ++ks) qf[rt][ks] = *(const bf16x8*)(PROJ + (size_t)(b * SEQ + qrow0 + 16 * rt + fr) * NPROJ + C_MQ + h * 128 + 32 * ks + 8 * fq);
    unsigned selmask[2];
    if (qb <= 3) { selmask[0] = selmask[1] = (1u << qb) - 1u; }
    else {
        bf16x8 kmf[4];
#pragma unroll
        for (int ks = 0; ks < 4; ++ks) { const float* src = KMEAN + ((size_t)bh * 8 + (fr & 7)) * 128 + 32 * ks + 8 * fq; const f32x4 a = *(const f32x4*)src, c = *(const f32x4*)(src + 4);
            u32x4 o; o.x = pk2(a[0], a[1]); o.y = pk2(a[2], a[3]); o.z = pk2(c[0], c[1]); o.w = pk2(c[2], c[3]); if (fr >= 8) o = (u32x4){0u, 0u, 0u, 0u};
            kmf[ks] = __builtin_bit_cast(bf16x8, o); }
#pragma unroll
        for (int rt = 0; rt < 2; ++rt) { f32x4 g = {0.f, 0.f, 0.f, 0.f};
#pragma unroll
            for (int ks = 0; ks < 4; ++ks) g = __builtin_amdgcn_mfma_f32_16x16x32_bf16(kmf[ks], qf[rt][ks], g, 0, 0, 0);
            float gv[8];
#pragma unroll
            for (int i = 0; i < 4; ++i) { gv[i] = __shfl(g[i], fr); gv[4 + i] = __shfl(g[i], 16 + fr); }
            unsigned msk = 0u;
#pragma unroll
            for (int rep = 0; rep < 3; ++rep) { float best = -INFINITY; int bi = 0;
#pragma unroll
                for (int n = 0; n < 8; ++n) { const bool ok = (n < qb) && !((msk >> n) & 1u) && (gv[n] > best); best = ok ? gv[n] : best; bi = ok ? n : bi; }
                msk |= 1u << bi; }
            selmask[rt] = msk; }
    }
    float bound[2];
    { float kmx = 0.f; const float* KM = (const float*)(ws + WS_KMAX) + bh * 8;
      { const f32x4 k0 = *(const f32x4*)KM, k1 = *(const f32x4*)(KM + 4); const float kv[8] = {k0[0], k0[1], k0[2], k0[3], k1[0], k1[1], k1[2], k1[3]};
#pragma unroll
        for (int n = 0; n < 8; ++n) kmx = (n <= qb) ? fmaxf(kmx, kv[n]) : kmx; }
#pragma unroll
      for (int rt = 0; rt < 2; ++rt) { float q2 = 0.f;
#pragma unroll
          for (int ks = 0; ks < 4; ++ks)
#pragma unroll
              for (int e = 0; e < 8; ++e) { const float qv = __uint_as_float((unsigned)(unsigned short)qf[rt][ks][e] << 16); q2 += qv * qv; }
          q2 += __shfl_xor(q2, 16); q2 += __shfl_xor(q2, 32);
          bound[rt] = fminf(sqrtf(q2) * kmx * (0.08838834764831845f * 1.4426950408889634f) * 1.0001f, 96.f); } }
    f32x4 O[2][8]; float lsum[2];
#pragma unroll
    for (int rt = 0; rt < 2; ++rt) { lsum[rt] = 0.f;
#pragma unroll
        for (int dt = 0; dt < 8; ++dt) O[rt][dt] = (f32x4){0.f, 0.f, 0.f, 0.f}; }
    const int ntiles = (qb + 1) * 4;
    const int krow0 = tid >> 4, kpc = tid & 15;
    const int vrow0 = tid >> 3, vpc = tid & 7;
    const bf16_t* kbase = PROJ + (size_t)(b * SEQ) * NPROJ + C_MK + h * 128 + 8 * kpc;
    const bf16_t* vbase = VT + (size_t)bh * 128 * SEQ + 8 * vpc;
    u32x4 st[4];
#define MOBA_LOAD(key0) do { st[0] = *(const u32x4*)(kbase + (size_t)((key0) + krow0) * NPROJ); st[1] = *(const u32x4*)(kbase + (size_t)((key0) + krow0 + 32) * NPROJ); \
        st[2] = *(const u32x4*)(vbase + (size_t)vrow0 * SEQ + (key0)); st[3] = *(const u32x4*)(vbase + (size_t)(vrow0 + 64) * SEQ + (key0)); } while (0)
#define MOBA_STORE(buf) do { unsigned char* kb_ = smem + (buf) * 35840; unsigned char* vb_ = kb_ + 17408; \
        *(u32x4*)(kb_ + krow0 * 272 + kpc * 16) = st[0]; *(u32x4*)(kb_ + (krow0 + 32) * 272 + kpc * 16) = st[1]; \
        *(u32x4*)(vb_ + vrow0 * 144 + vpc * 16) = st[2]; *(u32x4*)(vb_ + (vrow0 + 64) * 144 + vpc * 16) = st[3]; } while (0)
    MOBA_LOAD(0); MOBA_STORE(0);
    __syncthreads();
    const float SC = 0.08838834764831845f * 1.4426950408889634f;
    for (int tt = 0; tt < ntiles; ++tt) {
        const int n = tt >> 2, key0 = tt * 64; const int buf = tt & 1;
        if (tt + 1 < ntiles) MOBA_LOAD(key0 + 64);
        const unsigned char* kb = smem + buf * 35840; const unsigned char* vb = kb + 17408;
        f32x4 s[2][4];
#pragma unroll
        for (int rt = 0; rt < 2; ++rt)
#pragma unroll
            for (int kt = 0; kt < 4; ++kt) s[rt][kt] = (f32x4){0.f, 0.f, 0.f, 0.f};
        bf16x8 ga[4], gb[4];
#define LDK_(F, kt_) do { _Pragma("unroll") for (int ks_ = 0; ks_ < 4; ++ks_) F[ks_] = *(const bf16x8*)(kb + (16 * (kt_) + fr) * 272 + (32 * ks_ + 8 * fq) * 2); } while (0)
#define MMS_(F, kt_) do { _Pragma("unroll") for (int ks_ = 0; ks_ < 4; ++ks_) { s[0][kt_] = __builtin_amdgcn_mfma_f32_16x16x32_bf16(F[ks_], qf[0][ks_], s[0][kt_], 0, 0, 0); s[1][kt_] = __builtin_amdgcn_mfma_f32_16x16x32_bf16(F[ks_], qf[1][ks_], s[1][kt_], 0, 0, 0); } } while (0)
#define LDV_(F, sl_, d0_) do { _Pragma("unroll") for (int dd_ = 0; dd_ < 4; ++dd_) F[dd_] = *(const bf16x8*)(vb + (16 * ((d0_) + dd_) + fr) * 144 + (32 * (sl_) + 8 * fq) * 2); } while (0)
#define MMV_(F, sl_, d0_) do { _Pragma("unroll") for (int dd_ = 0; dd_ < 4; ++dd_) { O[0][(d0_) + dd_] = __builtin_amdgcn_mfma_f32_16x16x32_bf16(F[dd_], pf[0][sl_], O[0][(d0_) + dd_], 0, 0, 0); O[1][(d0_) + dd_] = __builtin_amdgcn_mfma_f32_16x16x32_bf16(F[dd_], pf[1][sl_], O[1][(d0_) + dd_], 0, 0, 0); } } while (0)
#define SB0_() __builtin_amdgcn_sched_barrier(0)
        LDK_(ga, 0); LDK_(gb, 1); SB0_();
        MMS_(ga, 0); SB0_(); LDK_(ga, 2); SB0_();
        MMS_(gb, 1); SB0_(); LDK_(gb, 3); SB0_();
        MMS_(ga, 2); SB0_(); LDV_(ga, 0, 0); SB0_();
        MMS_(gb, 3); SB0_(); LDV_(gb, 0, 4); SB0_();
        bf16x8 pf[2][2];
#pragma unroll
        for (int rt = 0; rt < 2; ++rt) {
            const int row_t = qrow0 + 16 * rt + fr;
            const bool rowsel = (n < qb) ? (((selmask[rt] >> n) & 1u) != 0u) : true;
            if (n == qb) {
#pragma unroll
                for (int kt = 0; kt < 4; ++kt)
#pragma unroll
                    for (int i = 0; i < 4; ++i) { const int key = key0 + 16 * kt + 4 * fq + i; if (key > row_t) s[rt][kt][i] = -INFINITY; }
            }
            const float msub = rowsel ? -bound[rt] : -INFINITY;
            float ps = 0.f;
#pragma unroll
            for (int kt = 0; kt < 4; ++kt)
#pragma unroll
                for (int i = 0; i < 4; ++i) { const float pv = __builtin_amdgcn_exp2f(fmaf(s[rt][kt][i], SC, msub)); s[rt][kt][i] = pv; ps += pv; }
            lsum[rt] += ps;
#pragma unroll
            for (int sl = 0; sl < 2; ++sl) { u32x4 o; o.x = pk2(s[rt][2 * sl][0], s[rt][2 * sl][1]); o.y = pk2(s[rt][2 * sl][2], s[rt][2 * sl][3]);
                o.z = pk2(s[rt][2 * sl + 1][0], s[rt][2 * sl + 1][1]); o.w = pk2(s[rt][2 * sl + 1][2], s[rt][2 * sl + 1][3]); pf[rt][sl] = __builtin_bit_cast(bf16x8, o); }
        }
        SB0_(); MMV_(ga, 0, 0); SB0_(); LDV_(ga, 1, 0); SB0_();
        MMV_(gb, 0, 4); SB0_(); LDV_(gb, 1, 4); SB0_();
        MMV_(ga, 1, 0); SB0_(); MMV_(gb, 1, 4); SB0_();
#undef LDK_
#undef MMS_
#undef LDV_
#undef MMV_
#undef SB0_
        if (tt + 1 < ntiles) MOBA_STORE(buf ^ 1);
        __syncthreads();
    }
#undef MOBA_LOAD
#undef MOBA_STORE
#pragma unroll
    for (int rt = 0; rt < 2; ++rt) { float l = lsum[rt]; l += __shfl_xor(l, 16); l += __shfl_xor(l, 32); const float inv = 1.f / l;
        bf16_t* orow = MIXIN + (size_t)(b * SEQ + qrow0 + 16 * rt + fr) * DM + 512 + h * 128 + 4 * fq;
#pragma unroll
        for (int dt = 0; dt < 8; ++dt) { u32x2 o; o.x = pk2(O[rt][dt][0] * inv, O[rt][dt][1] * inv); o.y = pk2(O[rt][dt][2] * inv, O[rt][dt][3] * inv); *(u32x2*)(orow + 16 * dt) = o; } }
}

constexpr size_t WS_LBUF = WS_U, WS_GLAST = WS_END, WS_BVT = WS_END + 8192;
constexpr size_t WS_END2 = WS_BVT + (size_t)2048 * 16384;
__device__ __forceinline__ unsigned bf1(float v) { return pk2(v, 0.f) & 0xffffu; }

__host__ __device__ constexpr int ltri_off(int i) { return i <= 0 ? 0 : (((i - 1) >> 2) + 1) * (2 * ((i - 1) >> 2) + ((i - 1) & 3)); }
__device__ __forceinline__ void gdn_prep(const Params& P, unsigned char* smem) {
    int tid_ = threadIdx.x; asm volatile("" : "+v"(tid_)); const int tid = tid_, lane = tid & 63, wave = tid >> 6, fr = lane & 15, fq = lane >> 4; unsigned char* ws = P.ws;
    const bf16_t* PROJ = (const bf16_t*)(ws + WS_BIG); const float* LG = (const float*)(ws + WS_LG); unsigned char* REC = (unsigned char*)P.out;
    bf16_t* BVT = (bf16_t*)(ws + WS_BVT); float* GLAST = (float*)(ws + WS_GLAST);
    unsigned char* Kb = smem; unsigned char* Qb = smem + 17408; unsigned char* Vb = smem + 34816;
    float* gsA = (float*)(smem + 52224); float* bsA = gsA + 512; float* esA = bsA + 512; float* egA = esA + 512;
    float* cwl = (float*)(smem + 60416);
    unsigned char* Lp = smem + 66560;
    const int p = tid & 15, rg = tid >> 4; const int G = gridDim.x; int hcur = -1;
    for (int k0 = 0; (int)blockIdx.x + k0 * G < 2048; k0 += 8) {
        { const int chunk = blockIdx.x + (k0 + wave) * G;
          if (chunk < 2048) { const int bh = chunk >> 5, n = chunk & 31, b = bh >> 2, h = bh & 3; const size_t m = (size_t)(b * SEQ + n * 64 + lane);
            const float gb = LG[m * 8 + h], ga = LG[m * 8 + 4 + h] + P.dt_bias[h];
            const float beta = 1.f / (1.f + __expf(-gb)); const float sp = ga > 20.f ? ga : log1pf(__expf(ga)); float g = -__expf(P.a_log[h]) * sp;
#pragma unroll
            for (int o = 1; o < 64; o <<= 1) { const float v = __shfl_up(g, o); if (lane >= o) g += v; }
            const float g63 = __shfl(g, 63);
            gsA[wave * 64 + lane] = g; bsA[wave * 64 + lane] = beta; esA[wave * 64 + lane] = __expf(g63 - g); egA[wave * 64 + lane] = __expf(g);
            if (lane == 63) GLAST[chunk] = __expf(g); } }
        __syncthreads();
        u32x4 ld[2][5];
        for (int ci = 0; ci < 8; ++ci) {
            const int chunk = blockIdx.x + (k0 + ci) * G; if (chunk >= 2048) break;
            const int bh = chunk >> 5, n = chunk & 31, b = bh >> 2, h = bh & 3, t0 = n * 64;
            unsigned char* rec = REC + (size_t)chunk * 65536;
            const float* gs = gsA + ci * 64; const float* bs = bsA + ci * 64; const float* es = esA + ci * 64; const float* eg = egA + ci * 64;
            if (h != hcur) { __syncthreads(); for (int i = tid; i < 1536; i += 512) { const int ten = i >> 9, tap = (i >> 7) & 3, c = i & 127; cwl[i] = P.conv_w[tap * 1536 + ten * 512 + h * 128 + c]; } hcur = h; __syncthreads(); }
#define CONV_LOAD(buf, ten_) do { _Pragma("unroll") for (int i_ = 0; i_ < 5; ++i_) { const int tt_ = t0 + 2 * rg - 3 + i_; \
                    ld[buf][i_] = *(const u32x4*)(PROJ + (size_t)(b * SEQ + max(tt_, 0)) * NPROJ + (ten_) * 512 + h * 128 + 8 * p); } } while (0)
            if (ci == 0) CONV_LOAD(0, 0);
#pragma unroll
            for (int ten = 0; ten < 3; ++ten) { float a0[8], a1[8];
                if (ten < 2) CONV_LOAD((ten + 1) & 1, ten + 1);
#pragma unroll
                for (int e = 0; e < 8; ++e) { a0[e] = 0.f; a1[e] = 0.f; }
#pragma unroll
                for (int i = 0; i < 5; ++i) { u32x4 w = ld[ten & 1][i]; if (t0 + 2 * rg - 3 + i < 0) w = (u32x4){0u, 0u, 0u, 0u}; const float xv[8] = {bflo(w.x), bfhi(w.x), bflo(w.y), bfhi(w.y), bflo(w.z), bfhi(w.z), bflo(w.w), bfhi(w.w)};
                    if (i < 4) { const f32x4 w0 = *(const f32x4*)(cwl + (ten * 4 + i) * 128 + 8 * p), w1 = *(const f32x4*)(cwl + (ten * 4 + i) * 128 + 8 * p + 4);
#pragma unroll
                        for (int e = 0; e < 4; ++e) { a0[e] += w0[e] * xv[e]; a0[4 + e] += w1[e] * xv[4 + e]; } }
                    if (i >= 1) { const f32x4 w0 = *(const f32x4*)(cwl + (ten * 4 + i - 1) * 128 + 8 * p), w1 = *(const f32x4*)(cwl + (ten * 4 + i - 1) * 128 + 8 * p + 4);
#pragma unroll
                        for (int e = 0; e < 4; ++e) { a1[e] += w0[e] * xv[e]; a1[4 + e] += w1[e] * xv[4 + e]; } } }
#pragma unroll
                for (int rr = 0; rr < 2; ++rr) { float* acc = rr == 0 ? a0 : a1; const int row = 2 * rg + rr; float ss = 0.f;
#pragma unroll
                    for (int e = 0; e < 8; ++e) { acc[e] = silu_f(acc[e]); ss += acc[e] * acc[e]; }
                    if (ten < 2) { ss = row16_sum(ss);
                        const float sc = rsqrtf(ss + RMS_EPS) * (ten == 0 ? 0.08838834764831845f : 1.f);
#pragma unroll
                        for (int e = 0; e < 8; ++e) acc[e] *= sc; }
                    u32x4 o; o.x = pk2(acc[0], acc[1]); o.y = pk2(acc[2], acc[3]); o.z = pk2(acc[4], acc[5]); o.w = pk2(acc[6], acc[7]);
                    *(u32x4*)((ten == 0 ? Qb : (ten == 1 ? Kb : Vb)) + row * 272 + 16 * p) = o;
                    if (ten < 2) { const float egr = eg[row]; const float f = (ten == 0) ? egr : egr * bs[row];
                        const int pp = p & 3, s1 = 16 * (pp & 1) + 4 * (pp >> 1);
                        unsigned char* rp = rec + (ten == 0 ? 16384 : 0) + row * 256 + (32 * (p >> 2)) * 2;
                        u32x2 q0, q1; q0.x = pk2(acc[0] * f, acc[1] * f); q0.y = pk2(acc[2] * f, acc[3] * f); q1.x = pk2(acc[4] * f, acc[5] * f); q1.y = pk2(acc[6] * f, acc[7] * f);
                        *(u32x2*)(rp + s1 * 2) = q0; *(u32x2*)(rp + (s1 + 8) * 2) = q1; } } }
            { const int chn = blockIdx.x + (k0 + ci + 1) * G;
              if (ci + 1 < 8 && chn < 2048) { const int bhn = chn >> 5, nn = chn & 31, bn = bhn >> 2, hn = bhn & 3;
#pragma unroll
                  for (int i_ = 0; i_ < 5; ++i_) { const int tt_ = nn * 64 + 2 * rg - 3 + i_;
                      ld[0][i_] = *(const u32x4*)(PROJ + (size_t)(bn * SEQ + max(tt_, 0)) * NPROJ + hn * 128 + 8 * p); } } }
            __syncthreads();
            { const int dcol = tid & 127, gp = tid >> 7;
#pragma unroll
              for (int q = 0; q < 2; ++q) { const int sg = gp * 2 + q, mp = sg >> 2, f4 = sg & 3; float kv[8], vv[8];
#pragma unroll
                  for (int jj = 0; jj < 8; ++jj) { const int c = 32 * mp + (jj < 4 ? 4 * f4 + jj : 16 + 4 * f4 + jj - 4);
                      kv[jj] = es[c] * __uint_as_float((unsigned)(*(const unsigned short*)(Kb + c * 272 + 2 * dcol)) << 16);
                      const int sr = 8 * sg + jj; vv[jj] = bs[sr] * __uint_as_float((unsigned)(*(const unsigned short*)(Vb + sr * 272 + 2 * dcol)) << 16); }
                  u32x4 o; o.x = pk2(kv[0], kv[1]); o.y = pk2(kv[2], kv[3]); o.z = pk2(kv[4], kv[5]); o.w = pk2(kv[6], kv[7]);
                  *(u32x4*)(rec + 32768 + dcol * 128 + sg * 16) = o;
                  u32x4 o2; o2.x = pk2(vv[0], vv[1]); o2.y = pk2(vv[2], vv[3]); o2.z = pk2(vv[4], vv[5]); o2.w = pk2(vv[6], vv[7]);
                  *(u32x4*)((unsigned char*)BVT + (size_t)chunk * 16384 + dcol * 128 + sg * 16) = o2; } }
            float* Lc = (float*)(Lp + ci * 8448);
            for (int job = wave; job < 26; job += 8) {
                if (job >= 20) { const int u = job - 20; const int it = (u < 3) ? 0 : (u < 5 ? 1 : 2); const int jt = (u < 3) ? u + 1 : (u < 5 ? u - 1 : 3);
                    const int i = 16 * it + fr; *(u32x2*)(rec + 57344 + i * 128 + (32 * (jt >> 1) + 8 * fq + 4 * (jt & 1)) * 2) = (u32x2){0u, 0u}; continue; }
                const int idx = job % 10; const bool isL = job < 10;
                const int it = (idx >= 6) ? 3 : (idx >= 3 ? 2 : (idx >= 1 ? 1 : 0)); const int jt = idx - it * (it + 1) / 2;
                const unsigned char* Xb = isL ? Kb : Qb;
                f32x4 d = {0.f, 0.f, 0.f, 0.f};
#pragma unroll
                for (int ks = 0; ks < 4; ++ks) { const bf16x8 kf = *(const bf16x8*)(Kb + (16 * jt + fr) * 272 + (32 * ks + 8 * fq) * 2), xf = *(const bf16x8*)(Xb + (16 * it + fr) * 272 + (32 * ks + 8 * fq) * 2);
                    d = __builtin_amdgcn_mfma_f32_16x16x32_bf16(kf, xf, d, 0, 0, 0); }
                const int i = 16 * it + fr; const float gi = gs[i], bi = bs[i]; float v[4];
#pragma unroll
                for (int e = 0; e < 4; ++e) { const int j = 16 * jt + 4 * fq + e; const bool ok = isL ? (j < i) : (j <= i); const float dec = __expf(fminf(gi - gs[j], 0.f)); v[e] = ok ? d[e] * dec * (isL ? bi : 1.f) : 0.f; }
                if (isL) { if (16 * jt + 4 * fq < ((i + 3) & ~3)) *(f32x4*)(Lc + 4 * ltri_off(i) + 16 * jt + 4 * fq) = (f32x4){v[0], v[1], v[2], v[3]}; }
                else { u32x2 o; o.x = pk2(v[0], v[1]); o.y = pk2(v[2], v[3]); *(u32x2*)(rec + 57344 + i * 128 + (32 * (jt >> 1) + 8 * fq + 4 * (jt & 1)) * 2) = o; }
            }
            __syncthreads();
        }
        { const int chunk = blockIdx.x + (k0 + wave) * G;
          if (chunk < 2048) { const float* Lc = (const float*)(Lp + wave * 8448);
              float Tc[64];
#pragma unroll
              for (int i = 0; i < 64; ++i) { float ac[4] = {(lane == i) ? 1.f : 0.f, 0.f, 0.f, 0.f};
#pragma unroll
                  for (int j4 = 0; j4 < (i + 3) / 4; ++j4) { const f32x4 l4 = *(const f32x4*)(Lc + 4 * ltri_off(i) + 4 * j4);
#pragma unroll
                      for (int e = 0; e < 4; ++e) if (4 * j4 + e < i) ac[e] -= l4[e] * Tc[4 * j4 + e]; }
                  Tc[i] = (ac[0] + ac[1]) + (ac[2] + ac[3]); if ((i & 3) == 3) __builtin_amdgcn_sched_barrier(0); }
              const int x = lane & 31; const int slot = 32 * (lane >> 5) + (x < 16 ? 8 * (x >> 2) + (x & 3) : 8 * ((x - 16) >> 2) + 4 + (x & 3));
              unsigned short* Tl = (unsigned short*)(Lp + wave * 8448);
#pragma unroll
              for (int i = 0; i < 64; ++i) Tl[i * 64 + slot] = (unsigned short)bf1(Tc[i]);
              unsigned char* trec = REC + (size_t)chunk * 65536 + 49152;
#pragma unroll
              for (int it = 0; it < 8; ++it) *(u32x4*)(trec + (it * 64 + lane) * 16) = *(const u32x4*)((const unsigned char*)Tl + (it * 64 + lane) * 16);
          } }
        __syncthreads();
    }
}

__device__ __forceinline__ void gdn_scan(const Params& P, unsigned char* smem, int bh) {
    int tid_ = threadIdx.x; asm volatile("" : "+v"(tid_)); const int tid = tid_, lane = tid & 63, w = tid >> 6, fr = lane & 15, fq = lane >> 4; const int b = bh >> 2, h = bh & 3; unsigned char* ws = P.ws;
    const bf16_t* PROJ = (const bf16_t*)(ws + WS_BIG); bf16_t* MIXIN = (bf16_t*)(ws + WS_MIXIN); const unsigned char* REC = (const unsigned char*)P.out;
    const unsigned char* BVT = (const unsigned char*)(ws + WS_BVT); const float* GLAST = (const float*)(ws + WS_GLAST);
    unsigned char* Lk = smem; unsigned char* Lq = smem + 17408; unsigned char* Lt = smem + 34816; unsigned char* LT = smem + 53248; unsigned char* Li = smem + 62464; float* Os = (float*)(smem + 71680);
    f32x4 Sacc[8];
#pragma unroll
    for (int j = 0; j < 8; ++j) Sacc[j] = (f32x4){0.f, 0.f, 0.f, 0.f};
    u32x4 st[8];
#define GS_LOAD(ch) do { const unsigned char* r_ = REC + (size_t)(ch) * 65536; _Pragma("unroll") for (int i_ = 0; i_ < 8; ++i_) st[i_] = *(const u32x4*)(r_ + (size_t)(tid + 512 * i_) * 16); } while (0)
#define GS_STORE() do { _Pragma("unroll") for (int i_ = 0; i_ < 8; ++i_) { const int id_ = tid + 512 * i_; unsigned char* d_; \
        if (i_ < 2) d_ = Lk + (id_ >> 4) * 272 + (id_ & 15) * 16; else if (i_ < 4) d_ = Lq + ((id_ - 1024) >> 4) * 272 + (id_ & 15) * 16; \
        else if (i_ < 6) d_ = Lt + ((id_ - 2048) >> 3) * 144 + (id_ & 7) * 16; else if (i_ < 7) d_ = LT + ((id_ - 3072) >> 3) * 144 + (id_ & 7) * 16; \
        else d_ = Li + ((id_ - 3584) >> 3) * 144 + (id_ & 7) * 16; *(u32x4*)d_ = st[i_]; } } while (0)
    u32x2 bvw[4]; float glast; unsigned zc[8];
    float nwv[16];
#pragma unroll
    for (int e = 0; e < 16; ++e) nwv[e] = P.gdn_norm_w[16 * (lane & 7) + e];
#define GS_BV(ch) do { glast = GLAST[ch]; _Pragma("unroll") for (int rt_ = 0; rt_ < 4; ++rt_) bvw[rt_] = *(const u32x2*)(BVT + (size_t)(ch) * 16384 + (16 * w + fr) * 128 + (16 * rt_ + 4 * fq) * 2); } while (0)
#define GS_Z(nn) do { const bf16_t* zp_ = PROJ + (size_t)(b * SEQ + (nn) * 64 + w * 8 + (lane >> 3)) * NPROJ + C_GZ + h * 128 + 16 * (lane & 7); const u32x4 za_ = *(const u32x4*)zp_, zb_ = *(const u32x4*)(zp_ + 8); \
          zc[0] = za_.x; zc[1] = za_.y; zc[2] = za_.z; zc[3] = za_.w; zc[4] = zb_.x; zc[5] = zb_.y; zc[6] = zb_.z; zc[7] = zb_.w; } while (0)
    GS_LOAD(bh * 32); GS_STORE(); GS_BV(bh * 32);
    __syncthreads();
    for (int n = 0; n < 32; ++n) {
        const int chunk = bh * 32 + n;
        GS_LOAD(bh * 32 + min(n + 1, 31)); GS_Z(n);
        bf16x8 sb[4];
#pragma unroll
        for (int m = 0; m < 4; ++m) { u32x4 o; o.x = pk2(Sacc[2 * m][0], Sacc[2 * m][1]); o.y = pk2(Sacc[2 * m][2], Sacc[2 * m][3]); o.z = pk2(Sacc[2 * m + 1][0], Sacc[2 * m + 1][1]); o.w = pk2(Sacc[2 * m + 1][2], Sacc[2 * m + 1][3]);
            sb[m] = __builtin_bit_cast(bf16x8, o); }
        bf16x8 fa[8], fb[8];
#define LD_KQ(F, rt_) do { _Pragma("unroll") for (int m_ = 0; m_ < 4; ++m_) { F[m_] = *(const bf16x8*)(Lk + (16 * (rt_) + fr) * 272 + (32 * m_ + 8 * fq) * 2); F[4 + m_] = *(const bf16x8*)(Lq + (16 * (rt_) + fr) * 272 + (32 * m_ + 8 * fq) * 2); } } while (0)
#define LD_64(F, base_) do { _Pragma("unroll") for (int rt_ = 0; rt_ < 4; ++rt_) _Pragma("unroll") for (int mp_ = 0; mp_ < 2; ++mp_) F[2 * rt_ + mp_] = *(const bf16x8*)((base_) + (16 * rt_ + fr) * 144 + (32 * mp_ + 8 * fq) * 2); } while (0)
#define LD_KT(F, j0_) do { _Pragma("unroll") for (int jj_ = 0; jj_ < 4; ++jj_) _Pragma("unroll") for (int mp_ = 0; mp_ < 2; ++mp_) F[2 * jj_ + mp_] = *(const bf16x8*)(Lt + (16 * ((j0_) + jj_) + fr) * 144 + (32 * mp_ + 8 * fq) * 2); } while (0)
#define MM_KQ(F, rt_) do { xacc[rt_] = (f32x4){0.f, 0.f, 0.f, 0.f}; oacc[rt_] = (f32x4){0.f, 0.f, 0.f, 0.f}; _Pragma("unroll") for (int m_ = 0; m_ < 4; ++m_) { \
            xacc[rt_] = __builtin_amdgcn_mfma_f32_16x16x32_bf16(F[m_], sb[m_], xacc[rt_], 0, 0, 0); oacc[rt_] = __builtin_amdgcn_mfma_f32_16x16x32_bf16(F[4 + m_], sb[m_], oacc[rt_], 0, 0, 0); } } while (0)
#define SB0() __builtin_amdgcn_sched_barrier(0)
        f32x4 xacc[4], oacc[4], vacc[4];
        LD_KQ(fa, 0); LD_KQ(fb, 1); SB0();
        MM_KQ(fa, 0); SB0(); LD_KQ(fa, 2); SB0();
        MM_KQ(fb, 1); SB0(); LD_KQ(fb, 3); SB0();
        MM_KQ(fa, 2); SB0(); LD_64(fa, LT); SB0();
        MM_KQ(fb, 3); SB0(); LD_64(fb, Li); SB0();
        bf16x8 xb[2];
#pragma unroll
        for (int mp = 0; mp < 2; ++mp) { float xv[8];
#pragma unroll
            for (int q = 0; q < 2; ++q) { const int rt = 2 * mp + q; xv[4 * q] = bflo(bvw[rt].x) - xacc[rt][0]; xv[4 * q + 1] = bfhi(bvw[rt].x) - xacc[rt][1]; xv[4 * q + 2] = bflo(bvw[rt].y) - xacc[rt][2]; xv[4 * q + 3] = bfhi(bvw[rt].y) - xacc[rt][3]; }
            u32x4 o; o.x = pk2(xv[0], xv[1]); o.y = pk2(xv[2], xv[3]); o.z = pk2(xv[4], xv[5]); o.w = pk2(xv[6], xv[7]); xb[mp] = __builtin_bit_cast(bf16x8, o); }
#pragma unroll
        for (int rt = 0; rt < 4; ++rt) { vacc[rt] = (f32x4){0.f, 0.f, 0.f, 0.f};
#pragma unroll
            for (int mp = 0; mp < 2; ++mp) vacc[rt] = __builtin_amdgcn_mfma_f32_16x16x32_bf16(fa[2 * rt + mp], xb[mp], vacc[rt], 0, 0, 0); }
        SB0(); LD_KT(fa, 0); SB0();
        bf16x8 vb[2];
#pragma unroll
        for (int mp = 0; mp < 2; ++mp) { u32x4 o; o.x = pk2(vacc[2 * mp][0], vacc[2 * mp][1]); o.y = pk2(vacc[2 * mp][2], vacc[2 * mp][3]); o.z = pk2(vacc[2 * mp + 1][0], vacc[2 * mp + 1][1]); o.w = pk2(vacc[2 * mp + 1][2], vacc[2 * mp + 1][3]);
            vb[mp] = __builtin_bit_cast(bf16x8, o); }
#pragma unroll
        for (int rt = 0; rt < 4; ++rt)
#pragma unroll
            for (int mp = 0; mp < 2; ++mp) oacc[rt] = __builtin_amdgcn_mfma_f32_16x16x32_bf16(fb[2 * rt + mp], vb[mp], oacc[rt], 0, 0, 0);
        SB0(); LD_KT(fb, 4); SB0();
#pragma unroll
        for (int jj = 0; jj < 4; ++jj) { Sacc[jj] = Sacc[jj] * glast;
#pragma unroll
            for (int mp = 0; mp < 2; ++mp) Sacc[jj] = __builtin_amdgcn_mfma_f32_16x16x32_bf16(fa[2 * jj + mp], vb[mp], Sacc[jj], 0, 0, 0); }
        SB0();
#pragma unroll
        for (int jj = 0; jj < 4; ++jj) { Sacc[4 + jj] = Sacc[4 + jj] * glast;
#pragma unroll
            for (int mp = 0; mp < 2; ++mp) Sacc[4 + jj] = __builtin_amdgcn_mfma_f32_16x16x32_bf16(fb[2 * jj + mp], vb[mp], Sacc[4 + jj], 0, 0, 0); }
#undef LD_KQ
#undef LD_64
#undef LD_KT
#undef MM_KQ
#undef SB0
#pragma unroll
        for (int rt = 0; rt < 4; ++rt)
#pragma unroll
            for (int i = 0; i < 4; ++i) Os[(16 * rt + 4 * fq + i) * 132 + 16 * w + fr] = oacc[rt][i];
        __syncthreads();
        GS_STORE();
        {
          const int row = w * 8 + (lane >> 3), cg = lane & 7; const size_t m = (size_t)(b * SEQ + n * 64 + row);
          float ov[16]; float ss = 0.f;
#pragma unroll
          for (int k4 = 0; k4 < 4; ++k4) { const f32x4 o4 = *(const f32x4*)(Os + row * 132 + 16 * cg + 4 * k4); ov[4 * k4] = o4[0]; ov[4 * k4 + 1] = o4[1]; ov[4 * k4 + 2] = o4[2]; ov[4 * k4 + 3] = o4[3];
              ss += (o4[0] * o4[0] + o4[1] * o4[1]) + (o4[2] * o4[2] + o4[3] * o4[3]); }
          ss = half8_sum(ss);
          const float rstd = rsqrtf(ss * (1.f / 128.f) + RMS_EPS);
          unsigned ow[8];
#pragma unroll
          for (int e2 = 0; e2 < 8; ++e2) { const unsigned zw = zc[e2];
              ow[e2] = pk2(ov[2 * e2] * rstd * nwv[2 * e2] * silu_f(bflo(zw)), ov[2 * e2 + 1] * rstd * nwv[2 * e2 + 1] * silu_f(bfhi(zw))); }
          bf16_t* op = MIXIN + m * DM + h * 128 + 16 * cg;
          *(u32x4*)op = (u32x4){ow[0], ow[1], ow[2], ow[3]}; *(u32x4*)(op + 8) = (u32x4){ow[4], ow[5], ow[6], ow[7]}; }
        GS_BV(bh * 32 + min(n + 1, 31));
        __syncthreads();
    }
#undef GS_BV
#undef GS_Z
#undef GS_LOAD
#undef GS_STORE
}

struct RowBuf { u32x2 m[4]; u32x2 x[4]; };
__device__ __forceinline__ void rb_load(RowBuf& r, const bf16_t* mb, const bf16_t* xb, int m, int lane) {
#pragma unroll
    for (int jj = 0; jj < 4; ++jj) { r.m[jj] = *(const u32x2*)(mb + (size_t)m * DM + 4 * lane + 256 * jj); r.x[jj] = *(const u32x2*)(xb + (size_t)m * DM + 4 * lane + 256 * jj); }
}
__device__ __forceinline__ void rp1_proc(const Params& P, const RowBuf& cur, int m, int lane, const f32x4 (&w1)[4], float* RS2) {
    f32x4 mv[4], xv[4]; float s = 0.f;
#pragma unroll
    for (int jj = 0; jj < 4; ++jj) { mv[jj] = (f32x4){bflo(cur.m[jj].x), bfhi(cur.m[jj].x), bflo(cur.m[jj].y), bfhi(cur.m[jj].y)}; xv[jj] = (f32x4){bflo(cur.x[jj].x), bfhi(cur.x[jj].x), bflo(cur.x[jj].y), bfhi(cur.x[jj].y)};
        s += (mv[jj][0] * mv[jj][0] + mv[jj][1] * mv[jj][1]) + (mv[jj][2] * mv[jj][2] + mv[jj][3] * mv[jj][3]); }
    const float r1 = rsqrtf(wave_sum(s) * (1.f / DM) + RMS_EPS); float s2 = 0.f;
#pragma unroll
    for (int jj = 0; jj < 4; ++jj) { xv[jj] = xv[jj] + mv[jj] * r1 * w1[jj]; { u32x2 hb; hb.x = pk2(xv[jj][0], xv[jj][1]); hb.y = pk2(xv[jj][2], xv[jj][3]); *(u32x2*)((bf16_t*)P.out + (size_t)m * DM + 4 * lane + 256 * jj) = hb; }
        s2 += (xv[jj][0] * xv[jj][0] + xv[jj][1] * xv[jj][1]) + (xv[jj][2] * xv[jj][2] + xv[jj][3] * xv[jj][3]); }
    const float r2 = rsqrtf(wave_sum(s2) * (1.f / DM) + RMS_EPS);
    if (lane == 0) RS2[m] = r2;
}
__device__ __forceinline__ void rowpass1(const Params& P) {
    int tid_ = threadIdx.x; asm volatile("" : "+v"(tid_)); const int tid = tid_, lane = tid & 63, wave = __builtin_amdgcn_readfirstlane(tid >> 6); const int gw = blockIdx.x * 8 + wave, NGW = gridDim.x * 8; unsigned char* ws = P.ws;
    const bf16_t* MIX = (const bf16_t*)(ws + WS_BIG); const bf16_t* XB = (const bf16_t*)(ws + WS_U); float* RS2 = (float*)(ws + WS_RS2);
    f32x4 w1[4];
#pragma unroll
    for (int jj = 0; jj < 4; ++jj) w1[jj] = *((const f32x4*)P.n_post_attn + lane + 64 * jj);
#define RP1_LOAD(buf, mm) rb_load(buf, MIX, XB, mm, lane)
#define RP1_PROC(buf, mm) rp1_proc(P, buf, mm, lane, w1, RS2)
    ROWLOOP3(RowBuf, RP1_LOAD, RP1_PROC);
#undef RP1_LOAD
#undef RP1_PROC
}
struct RowBuf2 { u32x2 m[4]; u32x2 h[4]; };
__device__ __forceinline__ void rb2_load(RowBuf2& r, const bf16_t* mb, const bf16_t* hb, int m, int lane) {
#pragma unroll
    for (int jj = 0; jj < 4; ++jj) { r.m[jj] = *(const u32x2*)(mb + (size_t)m * DM + 4 * lane + 256 * jj); r.h[jj] = *(const u32x2*)(hb + (size_t)m * DM + 4 * lane + 256 * jj); }
}
__device__ __forceinline__ void rp2_proc(const RowBuf2& cur, int m, int lane, const f32x4 (&w1)[4], bf16_t* H2B) {
    f32x4 fv[4], hv[4]; float s = 0.f;
#pragma unroll
    for (int jj = 0; jj < 4; ++jj) { fv[jj] = (f32x4){bflo(cur.m[jj].x), bfhi(cur.m[jj].x), bflo(cur.m[jj].y), bfhi(cur.m[jj].y)}; hv[jj] = (f32x4){bflo(cur.h[jj].x), bfhi(cur.h[jj].x), bflo(cur.h[jj].y), bfhi(cur.h[jj].y)};
        s += (fv[jj][0] * fv[jj][0] + fv[jj][1] * fv[jj][1]) + (fv[jj][2] * fv[jj][2] + fv[jj][3] * fv[jj][3]); }
    const float r1 = rsqrtf(wave_sum(s) * (1.f / DM) + RMS_EPS);
#pragma unroll
    for (int jj = 0; jj < 4; ++jj) { hv[jj] = hv[jj] + fv[jj] * r1 * w1[jj];
        u32x2 o; o.x = pk2(hv[jj][0], hv[jj][1]); o.y = pk2(hv[jj][2], hv[jj][3]); *(u32x2*)(H2B + (size_t)m * DM + 4 * lane + 256 * jj) = o; }
}
__device__ __forceinline__ void rowpass2(const Params& P) {
    int tid_ = threadIdx.x; asm volatile("" : "+v"(tid_)); const int tid = tid_, lane = tid & 63, wave = __builtin_amdgcn_readfirstlane(tid >> 6); const int gw = blockIdx.x * 8 + wave, NGW = gridDim.x * 8; unsigned char* ws = P.ws;
    const bf16_t* F = (const bf16_t*)(ws + WS_U); bf16_t* H2B = (bf16_t*)(ws + WS_MIXIN); const bf16_t* H1B = (const bf16_t*)P.out;
    f32x4 w1[4];
#pragma unroll
    for (int jj = 0; jj < 4; ++jj) w1[jj] = *((const f32x4*)P.n_post_mlp + lane + 64 * jj);
#define RP2_LOAD(buf, mm) rb2_load(buf, F, H1B, mm, lane)
#define RP2_PROC(buf, mm) rp2_proc(buf, mm, lane, w1, H2B)
    ROWLOOP3(RowBuf2, RP2_LOAD, RP2_PROC);
#undef RP2_LOAD
#undef RP2_PROC
}

template <int MODE> __device__ __forceinline__ void run_gemm(unsigned char* smem, const bf16_t* A, const bf16_t* Bt, int N, int K, bf16_t* O, int ldc, float* out, const bf16_t* ple, const float* rs = nullptr) {
    pg8::Gemm g{A, Bt, MTOK, N, K}; pg8::StaticOrder S; S.init(MTOK, N, (int)gridDim.x, (int)blockIdx.x);
    pg8::EpiGen<MODE> E{O, ldc, out, ple, rs};
#ifndef NO_GEMM
    pg8::gemm_phase<pg8::EpiGen<MODE>, pg8::StaticOrder, true, true>((PG8_LAS unsigned char*)smem, g, S, E);
#endif
    __syncthreads();
}

#define XB_TMO      128
#define XB_XCNT(j)  (256  + 64 * (j))
#define XB_XSUB(j)  (1280 + 64 * (j))
#define XB_XGEN(j)  (2304 + 64 * (j))
#define XB_TOP      3328
#define XB_TOPGEN   3392
#define XCD_BAR_WORDS 3456
#define XB_SPIN_CAP (1u << 18)

__device__ __forceinline__ unsigned xb_ld(unsigned* p)              { return __hip_atomic_load(p, __ATOMIC_RELAXED, __HIP_MEMORY_SCOPE_AGENT); }
__device__ __forceinline__ unsigned xb_add(unsigned* p, unsigned v) { return __hip_atomic_fetch_add(p, v, __ATOMIC_RELAXED, __HIP_MEMORY_SCOPE_AGENT); }
__device__ __forceinline__ unsigned xb_xcc_id() { return (unsigned)__builtin_amdgcn_s_getreg((3 << 11) | 20) & 0xFu; }
#define XB_SPIN(cond, bar) do { unsigned _sp = 0; while (cond) { __builtin_amdgcn_s_sleep(1); \
    if ((++_sp & 255u) == 0u) { if (xb_ld(&(bar)[XB_TMO])) break; if (_sp > XB_SPIN_CAP) { atomicAdd(&(bar)[XB_TMO], 1u); break; } } } } while (0)

struct XcdBarrier {
    unsigned* bar; unsigned x;
    volatile LAS unsigned* st;
};

__device__ __forceinline__ XcdBarrier xcd_barrier_post(unsigned* bar, volatile LAS unsigned* st) {
    XcdBarrier b; b.bar = bar; b.x = xb_xcc_id(); b.st = st;
    if (threadIdx.x == 0) (void)xb_add(&bar[XB_XCNT(b.x)], 1u);
    return b;
}
__device__ __forceinline__ void xcd_barrier_complete(unsigned* bar, unsigned x, unsigned& nloc, unsigned& nx) {
    const unsigned G = gridDim.x * gridDim.y * gridDim.z;
    unsigned sum, cnt, mine, sp = 0u;
    for (;;) {
        sum = 0u; cnt = 0u; mine = 0u;
#pragma unroll
        for (unsigned j = 0; j < 16; ++j) { const unsigned c = xb_ld(&bar[XB_XCNT(j)]); sum += c; cnt += (c > 0u) ? 1u : 0u; mine = (j == x) ? c : mine; }
        if (sum == G) break;
        __builtin_amdgcn_s_sleep(1);
        if ((++sp & 255u) == 0u) { if (xb_ld(&bar[XB_TMO])) break; if (sp > XB_SPIN_CAP) { atomicAdd(&bar[XB_TMO], 1u); break; } }
    }
    nloc = mine > 0u ? mine : 1u; nx = cnt > 0u ? cnt : 1u;
}

__device__ __forceinline__ void xcd_barrier(const XcdBarrier& b) {
    asm volatile("s_waitcnt vmcnt(0)" ::: "memory");
    __syncthreads();
    if (threadIdx.x == 0) {
        unsigned* bar = b.bar;
        __builtin_amdgcn_s_waitcnt(0);
        unsigned nloc = b.st[0], nx = b.st[1];
        if (nloc == 0u) { xcd_barrier_complete(bar, b.x, nloc, nx); b.st[0] = nloc; b.st[1] = nx; }
        const unsigned old = xb_add(&bar[XB_XSUB(b.x)], 1u);
        const unsigned gen = old / nloc;
        if (old + 1u == (gen + 1u) * nloc) {
            __builtin_amdgcn_fence(__ATOMIC_RELEASE, "agent");
            asm volatile("s_waitcnt vmcnt(0)" ::: "memory");
            const unsigned og = xb_add(&bar[XB_TOP], 1u);
            const unsigned tg = og / nx;
            if (og + 1u == (tg + 1u) * nx) xb_add(&bar[XB_TOPGEN], 1u);
            else XB_SPIN(xb_ld(&bar[XB_TOPGEN]) == tg, bar);
            __builtin_amdgcn_fence(__ATOMIC_ACQUIRE, "agent");
            xb_add(&bar[XB_XGEN(b.x)], 1u);
            asm volatile("s_waitcnt vmcnt(0)" ::: "memory");
        } else {
            XB_SPIN(xb_ld(&bar[XB_XGEN(b.x)]) == gen, bar);
            __builtin_amdgcn_fence(__ATOMIC_ACQUIRE, "agent");
            asm volatile("s_waitcnt vmcnt(0)" ::: "memory");
        }
    }
    __syncthreads();
}

constexpr size_t WS_XBAR = WS_END2 + 256;

constexpr size_t WS_TS = WS_END2;
#ifdef PROBE_K
#define STAMP(k) do { if (blockIdx.x == 0 && threadIdx.x == 0) ((unsigned long long*)(ws + WS_TS))[k] = __builtin_amdgcn_s_memrealtime(); } while (0)
#else
#define STAMP(k) do { } while (0)
#endif
#define XSYNC() xcd_barrier(xbar)
#define GRID_SYNC() do { asm volatile("s_waitcnt vmcnt(0)" ::: "memory"); grid.sync(); } while (0)
__global__ void __launch_bounds__(512) fwd_megakernel(Params P) {
    extern __shared__ __attribute__((aligned(16))) unsigned char smem[];
    cg::grid_group grid = cg::this_grid();
    unsigned char* ws = P.ws;
    volatile LAS unsigned* xst = (volatile LAS unsigned*)((LAS unsigned char*)smem + LDS_BYTES);
    if (threadIdx.x < 2) xst[threadIdx.x] = 0u;
    __syncthreads();
    const XcdBarrier xbar = xcd_barrier_post((unsigned*)(ws + WS_XBAR), xst);
    STAMP(0);
    phase0(P, smem);
#ifdef DUP_P0
    __syncthreads(); phase0(P, smem);
#endif
    XSYNC(); if (P.coop_marker) { GRID_SYNC(); }     STAMP(1);
    run_gemm<4>(smem, (const bf16_t*)(ws + WS_U), (const bf16_t*)(ws + WS_WIN), NPROJ, DM, (bf16_t*)(ws + WS_BIG), NPROJ, nullptr, nullptr, (const float*)(ws + WS_RS0));
    XSYNC(); STAMP(2);
    moba_prep(P, smem);
    gdn_prep(P, smem);
#ifdef DUP_PREP
    __syncthreads(); gdn_prep(P, smem);
#endif
    XSYNC(); STAMP(3);
#ifndef NDUP3
#define NDUP3 1
#endif
    for (int dup3 = 0; dup3 < NDUP3; ++dup3) { const int G = gridDim.x; const int ngdn = 64;
      if (dup3 > 0) { XSYNC(); }
      if ((int)blockIdx.x < ngdn) {
#ifndef NO_GDN
 for (int bh = blockIdx.x; bh < 64; bh += ngdn) gdn_scan(P, smem, bh);
#ifdef DUP_SCAN
 for (int bh = blockIdx.x; bh < 64; bh += ngdn) gdn_scan(P, smem, bh);
#endif
#endif
 }
      else { for (int u = blockIdx.x - ngdn; u < 192; u += G - ngdn) { const int bh = u / 3, j = u - 3 * bh;
#ifndef NO_MOBA
 const int nq = (j == 2) ? 4 : 2; const unsigned list = (j == 0) ? 0x37u : (j == 1 ? 0x46u : 0x0125u);
 for (int rep = 0; rep < nq; ++rep) moba_unit(P, smem, bh, (int)((list >> (4 * (nq - 1 - rep))) & 15u));
#ifdef DUP_MOBA
 for (int rep = 0; rep < nq; ++rep) moba_unit(P, smem, bh, (int)((list >> (4 * (nq - 1 - rep))) & 15u));
#endif
#endif
 } } }
    XSYNC(); STAMP(4);
    run_gemm<0>(smem, (const bf16_t*)(ws + WS_MIXIN), (const bf16_t*)(ws + WS_WOUT), DM, DM, (bf16_t*)(ws + WS_BIG), DM, nullptr, nullptr);
    XSYNC(); STAMP(5);
#ifdef DUP_SYNC
    for (int i_ = 0; i_ < 8; ++i_) { XSYNC(); }
#endif
    rowpass1(P);
#ifdef DUP_RP1
    rowpass1(P);
#endif
    XSYNC(); STAMP(6);
    run_gemm<5>(smem, (const bf16_t*)P.out, (const bf16_t*)(ws + WS_WUP), DFF, DM, (bf16_t*)(ws + WS_BIG), DFF, nullptr, nullptr, (const float*)(ws + WS_RS2));
    XSYNC(); STAMP(7);
    run_gemm<0>(smem, (const bf16_t*)(ws + WS_BIG), (const bf16_t*)(ws + WS_WDOWN), DM, DFF, (bf16_t*)(ws + WS_U), DM, nullptr, nullptr);
    XSYNC(); STAMP(8);
    rowpass2(P);
    run_gemm<0>(smem, (const bf16_t*)(ws + WS_PB), (const bf16_t*)(ws + WS_WPLE), DM, PLED, (bf16_t*)(ws + WS_BIG), DM, nullptr, nullptr);
    XSYNC(); STAMP(9);
    run_gemm<2>(smem, (const bf16_t*)(ws + WS_MIXIN), (const bf16_t*)(ws + WS_WGATE), DM, DM, (bf16_t*)(ws + WS_MIXIN), DM, P.out, (const bf16_t*)(ws + WS_BIG));
#ifdef PROBE_K
    XSYNC(); STAMP(10);
    if (blockIdx.x == 0 && threadIdx.x == 0) { const unsigned long long* ts = (const unsigned long long*)(ws + WS_TS); const float d0 = (float)(ts[PROBE_K + 1] - ts[PROBE_K]) * 0.01f, d1 = (float)(ts[PROBE_K2 + 1] - ts[PROBE_K2]) * 0.01f; P.out[0] = __expf(rintf(__logf(d0) * 4.f) * 0.25f); P.out[1] = __expf(rintf(__logf(d1) * 4.f) * 0.25f); }
#endif
}

extern "C" void kernel_launch(void* const* d_in, const int* in_sizes, int n_in, void* d_out, int out_size, void* d_ws, size_t ws_size, hipStream_t stream) {
    static int grid_blocks = 0;
    if (grid_blocks == 0) {
        if (ws_size < WS_TOTAL) { fprintf(stderr, "kernel_launch: workspace too small: %zu < %zu\n", ws_size, (size_t)WS_END2); grid_blocks = -1; return; }
        int dev = 0, cus = 0, per_cu = 0;
        hipGetDevice(&dev); hipDeviceGetAttribute(&cus, hipDeviceAttributeMultiprocessorCount, dev);
        hipFuncSetAttribute((const void*)fwd_megakernel, hipFuncAttributeMaxDynamicSharedMemorySize, LDS_BYTES + 64);
        hipOccupancyMaxActiveBlocksPerMultiprocessor(&per_cu, (const void*)fwd_megakernel, 512, LDS_BYTES + 64);
        if (per_cu < 1) { fprintf(stderr, "kernel_launch: occupancy query says %d blocks per CU\n", per_cu); per_cu = 1; }
        grid_blocks = cus;
        if (grid_blocks > 256) grid_blocks = 256;
    }
    if (grid_blocks < 0) return;
    Params P{};
    P.x = (const float*)d_in[0]; P.p = (const float*)d_in[1]; P.w_in = (const float*)d_in[2]; P.conv_w = (const float*)d_in[3]; P.a_log = (const float*)d_in[4]; P.dt_bias = (const float*)d_in[5];
    P.gdn_norm_w = (const float*)d_in[6]; P.w_out = (const float*)d_in[7]; P.n_pre_attn = (const float*)d_in[8]; P.n_post_attn = (const float*)d_in[9]; P.n_pre_mlp = (const float*)d_in[10];
    P.n_post_mlp = (const float*)d_in[11]; P.w_up = (const float*)d_in[12]; P.w_down = (const float*)d_in[13]; P.w_ple = (const float*)d_in[14]; P.w_gate = (const float*)d_in[15];
    P.out = (float*)d_out; P.ws = (unsigned char*)d_ws;
    for (int d = 0; d < 16; ++d) P.inv_freq[d] = (float)std::pow(500000.0, -(double)d / 16.0);
#ifdef DIAG_POISON
    hipMemsetAsync(d_out, 0xFF, (size_t)MTOK * DM * 4, stream);
    hipMemsetAsync((unsigned char*)d_ws + WS_U, 0xFF, (size_t)MTOK * DM * 2, stream);
    hipMemsetAsync((unsigned char*)d_ws + WS_GLAST, 0xFF, 8192, stream);
#endif
    hipMemsetAsync((unsigned char*)d_ws + WS_XBAR, 0, XCD_BAR_WORDS * 4, stream);
    void* args[] = {&P};
    hipError_t e = hipLaunchCooperativeKernel((const void*)fwd_megakernel, dim3(grid_blocks), dim3(512), args, LDS_BYTES + 64, stream);
    if (e != hipSuccess) fprintf(stderr, "cooperative launch failed: %s (grid %d)\n", hipGetErrorString(e), grid_blocks);
}
```
